# Optimizing an MI355X kernel written in HIP

```python
import jax, jax.numpy as jnp
from jax import lax
import numpy as np

D_MODEL = 1024
BATCH = 8
SEQ = 4096
DEPTH = 1

HEAD_DIM = 64
RWKV_HEADS = 8
FOX_HEADS = 8
RWKV_WIDTH = RWKV_HEADS * HEAD_DIM
FOX_WIDTH = FOX_HEADS * HEAD_DIM
DECAY_RANK = 64
ICLR_RANK = 64
GATE_RANK = 128
D_FF = 4 * D_MODEL
Q_BLOCK = 128
NORM_EPS = 1e-6
GN_EPS = 64e-5
N_MOD = 6

RWKV_COLS = (RWKV_WIDTH, DECAY_RANK, RWKV_WIDTH, RWKV_WIDTH, ICLR_RANK, GATE_RANK)
FOX_COLS = (FOX_WIDTH, FOX_WIDTH, FOX_WIDTH, FOX_HEADS)
GATE_COLS = (D_MODEL, D_MODEL)
N_RWKV = 3 * RWKV_WIDTH + DECAY_RANK + ICLR_RANK + GATE_RANK
N_FOX = 3 * FOX_WIDTH + FOX_HEADS
N_GATE = 2 * D_MODEL
N_IN = N_RWKV + N_FOX + N_GATE

kernel_name = "rwkv7_fox_gated_hybrid_block"


def _split(t, sizes):
    idx = np.cumsum(np.array(sizes))[:-1].tolist()
    return jnp.split(t, idx, axis=-1)


def _rmsnorm(x, g):
    xf = x.astype(jnp.float32)
    y = xf * lax.rsqrt(jnp.mean(xf * xf, axis=-1, keepdims=True) + NORM_EPS)
    return (y * g.astype(jnp.float32)).astype(x.dtype)


def _modulate(x, g, shift, scale):
    return _rmsnorm(x, g) * (1.0 + scale[:, None, :]) + shift[:, None, :]


def _rwkv7_mix(p, w_decay_up, decay_base, w_iclr_up, iclr_base, w_gate_up,
               kk_scale, k_iclr_mix, r_bonus, lnx_w, lnx_b):
    B, S, _ = p.shape
    H, N = RWKV_HEADS, HEAD_DIM
    f32 = jnp.float32
    r, wd, k, v, ad, gd = _split(p, RWKV_COLS)
    w = -jax.nn.softplus(-(decay_base + jnp.tanh(wd) @ w_decay_up)) - 0.5
    decay = jnp.exp(-jnp.exp(w.astype(f32)))
    a = jax.nn.sigmoid(iclr_base + ad @ w_iclr_up)
    g = jax.nn.sigmoid(gd) @ w_gate_up
    heads = lambda t: t.reshape(B, S, H, N).astype(f32)
    kk = heads(k * kk_scale)
    kk = kk / jnp.maximum(jnp.sqrt(jnp.sum(kk * kk, axis=-1, keepdims=True)), 1e-12)
    k = heads(k * (1.0 + (a - 1.0) * k_iclr_mix))
    r_h, v_h, a_h, w_h = heads(r), heads(v), heads(a), heads(decay)
    a_vec = -kk
    b_vec = kk * a_h
    tm = lambda t: jnp.transpose(t, (1, 0, 2, 3))

    def step(state, inp):
        r_t, w_t, k_t, v_t, a_t, b_t = inp
        sa = jnp.einsum('bhij,bhj->bhi', state, a_t)
        state = (state * w_t[:, :, None, :] + sa[..., None] * b_t[:, :, None, :]
                 + v_t[..., None] * k_t[:, :, None, :])
        y_t = jnp.einsum('bhij,bhj->bhi', state, r_t)
        return state, y_t

    state0 = jnp.zeros((B, H, N, N), f32)
    _, y = lax.scan(step, state0, (tm(r_h), tm(w_h), tm(k), tm(v_h), tm(a_vec), tm(b_vec)))
    y = jnp.transpose(y, (1, 0, 2, 3))
    mu = jnp.mean(y, axis=-1, keepdims=True)
    var = jnp.mean(jnp.square(y - mu), axis=-1, keepdims=True)
    y = ((y - mu) * lax.rsqrt(var + GN_EPS)).reshape(B, S, H * N)
    y = y * lnx_w.astype(f32) + lnx_b.astype(f32)
    bonus = jnp.sum(r_h * k * r_bonus.astype(f32), axis=-1, keepdims=True) * v_h
    y = y + bonus.reshape(B, S, H * N)
    return (y.astype(p.dtype) * g)


def _forgetting_attention(q, k, v, f_logit, f_bias):
    B, S, _ = q.shape
    H, Dh = FOX_HEADS, HEAD_DIM
    nb = S // Q_BLOCK
    scale = 1.0 / np.sqrt(Dh).astype(np.float32)
    to_h = lambda t: t.reshape(B, S, H, Dh).transpose(0, 2, 1, 3)
    q, k, v = to_h(q), to_h(k), to_h(v)
    logf = jax.nn.log_sigmoid((f_logit + f_bias).astype(jnp.float32))
    cum = jnp.cumsum(logf, axis=1).transpose(0, 2, 1)
    qb = q.reshape(B, H, nb, Q_BLOCK, Dh).transpose(2, 0, 1, 3, 4)
    cb = cum.reshape(B, H, nb, Q_BLOCK).transpose(2, 0, 1, 3)
    kpos = jnp.arange(S)

    def block(args):
        qi, ci, i = args
        qpos = i * Q_BLOCK + jnp.arange(Q_BLOCK)
        s = (jnp.einsum('bhqd,bhkd->bhqk', qi, k).astype(jnp.float32) * scale
             + ci[..., :, None] - cum[..., None, :])
        s = jnp.where(kpos[None, :] <= qpos[:, None], s, -jnp.inf)
        pr = jax.nn.softmax(s, axis=-1)
        return jnp.einsum('bhqk,bhkd->bhqd', pr.astype(v.dtype), v)

    o = lax.map(block, (qb, cb, jnp.arange(nb)))
    return o.transpose(1, 0, 3, 2, 4).reshape(B, S, H * Dh)


def setup_inputs(seed: int = 0) -> dict:
    key = jax.random.key(seed)
    ks = jax.random.split(key, 32)
    L, D = DEPTH, D_MODEL
    nrm = lambda k, shape, s: jax.random.normal(k, shape, jnp.float32) * s
    uni = lambda k, shape, lo, hi: jax.random.uniform(k, shape, jnp.float32, lo, hi)
    return {
        "x": nrm(ks[0], (BATCH, SEQ, D), 1.0),
        "c": nrm(ks[1], (BATCH, D), 1.0),
        "w_ada": nrm(ks[2], (L, D, N_MOD * D), 0.5 * D ** -0.5),
        "b_ada": nrm(ks[3], (L, N_MOD * D), 0.02),
        "norm1_g": 1.0 + nrm(ks[4], (L, D), 0.02),
        "w_in": nrm(ks[5], (L, D, N_IN), D ** -0.5),
        "mu_shift": uni(ks[6], (L, N_RWKV), 0.0, 1.0),
        "w_decay_up": nrm(ks[7], (L, DECAY_RANK, RWKV_WIDTH), DECAY_RANK ** -0.5),
        "decay_base": uni(ks[8], (L, RWKV_WIDTH), -5.0, 1.0),
        "w_iclr_up": nrm(ks[9], (L, ICLR_RANK, RWKV_WIDTH), ICLR_RANK ** -0.5),
        "iclr_base": nrm(ks[10], (L, RWKV_WIDTH), 0.1),
        "w_gate_up": nrm(ks[11], (L, GATE_RANK, RWKV_WIDTH), GATE_RANK ** -0.5),
        "kk_scale": 0.85 + nrm(ks[12], (L, RWKV_WIDTH), 0.05),
        "k_iclr_mix": 1.0 + nrm(ks[13], (L, RWKV_WIDTH), 0.05),
        "r_bonus": nrm(ks[14], (L, RWKV_HEADS, HEAD_DIM), 0.1),
        "lnx_w": 1.0 + nrm(ks[15], (L, RWKV_WIDTH), 0.02),
        "lnx_b": nrm(ks[16], (L, RWKV_WIDTH), 0.02),
        "fox_f_bias": uni(ks[17], (L, FOX_HEADS), 1.0, 4.0),
        "w_o_rwkv": nrm(ks[18], (L, RWKV_WIDTH, D), RWKV_WIDTH ** -0.5),
        "w_o_fox": nrm(ks[19], (L, FOX_WIDTH, D), FOX_WIDTH ** -0.5),
        "w_out": nrm(ks[20], (L, D, D), D ** -0.5),
        "norm2_g": 1.0 + nrm(ks[21], (L, D), 0.02),
        "w_ff1": nrm(ks[22], (L, D, D_FF), D ** -0.5),
        "w_ff2": nrm(ks[23], (L, D_FF, D), D_FF ** -0.5),
        "final_g": 1.0 + nrm(ks[24], (D,), 0.02),
    }


def reference(x, c, w_ada, b_ada, norm1_g, w_in, mu_shift, w_decay_up, decay_base, w_iclr_up,
              iclr_base, w_gate_up, kk_scale, k_iclr_mix, r_bonus, lnx_w, lnx_b, fox_f_bias,
              w_o_rwkv, w_o_fox, w_out, norm2_g, w_ff1, w_ff2, final_g):
    c_act = jax.nn.silu(c)
    for l in range(DEPTH):
        mod = c_act @ w_ada[l] + b_ada[l]
        sh1, sc1, gt1, sh2, sc2, gt2 = jnp.split(mod, N_MOD, axis=-1)

        h = _modulate(x, norm1_g[l], sh1, sc1)
        proj = h @ w_in[l]
        p_rwkv, p_fox, p_gate = _split(proj, (N_RWKV, N_FOX, N_GATE))
        prev = jnp.pad(p_rwkv[:, :-1], ((0, 0), (1, 0), (0, 0)))
        p_rwkv = p_rwkv + mu_shift[l] * (prev - p_rwkv)
        y_a = _rwkv7_mix(p_rwkv, w_decay_up[l], decay_base[l], w_iclr_up[l], iclr_base[l],
                         w_gate_up[l], kk_scale[l], k_iclr_mix[l], r_bonus[l], lnx_w[l], lnx_b[l])
        fq, fk, fv, ff = _split(p_fox, FOX_COLS)
        y_b = _forgetting_attention(fq, fk, fv, ff, fox_f_bias[l])
        g_a, g_b = _split(p_gate, GATE_COLS)
        merged = (jax.nn.sigmoid(g_a) * (y_a @ w_o_rwkv[l])
                  + jax.nn.sigmoid(g_b) * (y_b @ w_o_fox[l]))
        x = x + gt1[:, None, :] * (merged @ w_out[l])

        h2 = _modulate(x, norm2_g[l], sh2, sc2)
        ff_out = jnp.square(jax.nn.relu(h2 @ w_ff1[l])) @ w_ff2[l]
        x = x + gt2[:, None, :] * ff_out
    return _rmsnorm(x, final_g)
```

```cpp
#include <hip/hip_runtime.h>
#include <hip/hip_cooperative_groups.h>
#include <cstdio>
#include <cstdint>
namespace cg = cooperative_groups;

#ifndef N_LAUNCH_MODE
#define N_LAUNCH_MODE 1
#endif

#define LAS __attribute__((address_space(3)))
typedef unsigned short bf16_t;
typedef short bf16x8 __attribute__((ext_vector_type(8)));
typedef float f32x4 __attribute__((ext_vector_type(4)));
typedef float f32x2 __attribute__((ext_vector_type(2)));
typedef float f32x16 __attribute__((ext_vector_type(16)));
typedef unsigned u32x4 __attribute__((ext_vector_type(4)));
typedef unsigned u32x2 __attribute__((ext_vector_type(2)));

constexpr int NB = 8, SEQ = 4096, DM = 1024, T = NB * SEQ, NH = 8, HD = 64, RW = 512, DFF = 4096, NMOD = 6144;
constexpr int N_IN = 5384, NPROJ = 5632;
constexpr int C_R = 0, C_K = 512, C_V = 1024, C_WD = 1536, C_AD = 1600, C_GD = 1664, C_FQ = 1792, C_FK = 2304, C_FV = 2816, C_GA = 3328, C_GB = 4352, C_FL = 5376;
constexpr float NORM_EPS = 1e-6f, GN_EPS = 64e-5f, LOG2E = 1.4426950408889634f;
constexpr int NWAVES = 8, NTHREADS = 512, LDS_BYTES = 135168;
constexpr int NPHASE = 13;

constexpr size_t MiB = 1u << 20;
constexpr size_t WS_WIN = 0, WS_WOA = 11 * MiB, WS_WOB = 12 * MiB, WS_WOUT = 13 * MiB, WS_WFF1 = 15 * MiB, WS_WFF2 = 23 * MiB;
constexpr size_t WS_MOD = 31 * MiB, WS_CUM = 32 * MiB;
constexpr size_t WS_H = 36 * MiB;
constexpr size_t WS_B = 36 * MiB, WS_W16 = 68 * MiB;
constexpr size_t WS_PROJ = 100 * MiB;
constexpr size_t WS_G = 452 * MiB;
constexpr size_t WS_END = 484 * MiB;

__device__ __forceinline__ unsigned f2bf(float f) { unsigned u = __builtin_bit_cast(unsigned, f); return (u + 0x7fffu + ((u >> 16) & 1u)) >> 16; }
__device__ __forceinline__ unsigned pk2(float lo, float hi) { return f2bf(lo) | (f2bf(hi) << 16); }
__device__ __forceinline__ float bf2f(bf16_t h) { return __builtin_bit_cast(float, (unsigned)h << 16); }
__device__ __forceinline__ float bflo(unsigned w) { return __builtin_bit_cast(float, w << 16); }
__device__ __forceinline__ float bfhi(unsigned w) { return __builtin_bit_cast(float, w & 0xffff0000u); }
__device__ __forceinline__ float sigmoidf_(float x) { return 1.f / (1.f + __expf(-x)); }
__device__ __forceinline__ float wave_sum(float v) {
#pragma unroll
    for (int o = 1; o < 64; o <<= 1) v += __shfl_xor(v, o);
    return v;
}
#define LDS_WAIT() asm volatile("s_waitcnt lgkmcnt(0)" ::: "memory")

__device__ __forceinline__ int win_src_col(int n) {
    if (n < 512) return n;
    if (n < 1536) return n + 64;
    if (n < 1600) return n - 1024;
    if (n < 3328) return n;
    if (n < 5376) return n + 8;
    if (n < 5384) return n - 2048;
    return -1;
}

namespace pg8 {
constexpr int BM = 256, BK = 64, HALF = 128, HTB = HALF * BK * 2, STAGE_BYTES = 8 * HTB, NXCD = 8, WGM = 8;
__host__ __device__ __forceinline__ int lds_byte(int r, int c) { const int st = (r >> 4) * 2 + (c >> 5), rr = r & 15, cc = c & 31, ob = rr * 64 + cc * 2; return st * 1024 + (ob ^ (((ob >> 9) & 1) << 5)); }
__host__ __device__ __forceinline__ void stage_rc(int b, int& R, int& C) { const int st = b / 1024, sb = b % 1024, swz = sb ^ (((sb >> 9) & 1) << 5); R = (st >> 1) * 16 + swz / 64; C = (st & 1) * 32 + (swz % 64) / 2; }
__host__ __device__ __forceinline__ int perm32(int rho) { const int n = rho >> 4, i = rho & 15; return 8 * (i >> 2) + 4 * n + (i & 3); }
struct Unit { int pm, pn; };
struct Gemm { const bf16_t* A; const bf16_t* Bt; int M, N, K, lda; };
struct StaticOrder {
    int nM, nN, nwg, G, c;
    __device__ void init(int M, int N, int G_, int c_) { nM = M / BM; nN = N / BM; nwg = nM * nN; G = G_; c = c_; }
    __device__ bool next(int i, Unit& u) const {
        const long L = (long)i * G + c; if (L >= nwg) return false;
        int wgid = (int)L; { const int q = nwg / NXCD, r = nwg % NXCD, xcd = wgid % NXCD, off = wgid / NXCD; wgid = (xcd < r ? xcd * (q + 1) : r * (q + 1) + (xcd - r) * q) + off; }
        const int nig = WGM * nN, gid = wgid / nig, fm = gid * WGM, gsz = (nM - fm) < WGM ? (nM - fm) : WGM;
        u.pm = fm + ((wgid % nig) % gsz); u.pn = (wgid % nig) / gsz; return true;
    }
};
__device__ __forceinline__ unsigned cvt_pk_bf16(float lo, float hi) { unsigned r; asm volatile("v_cvt_pk_bf16_f32 %0, %1, %2" : "=v"(r) : "v"(lo), "v"(hi)); return r; }

template <int MODE> struct Epi {
    bf16_t* O; int ldo; float* F; const float* X; const float* gate; const bf16_t* P; int gcol;
    __device__ __forceinline__ void operator()(const f32x4 (&acc)[2][2][4][2], const Unit& u, int wr, int wc, int fr, int fq) const {
        const int row0 = u.pm * BM + wr * 64 + fr, col0 = u.pn * BM + wc * 32 + 8 * fq;
#pragma unroll
        for (int ai = 0; ai < 2; ++ai)
#pragma unroll
            for (int m = 0; m < 4; ++m) {
                const int row = row0 + ai * HALF + m * 16;
#pragma unroll
                for (int bj = 0; bj < 2; ++bj) {
                    const int col = col0 + bj * HALF;
                    f32x4 v0 = acc[ai][bj][m][0], v1 = acc[ai][bj][m][1];
                    if (MODE == 1) {
#pragma unroll
                        for (int j = 0; j < 4; ++j) { float a = fmaxf(v0[j], 0.f), b = fmaxf(v1[j], 0.f); v0[j] = a * a; v1[j] = b * b; }
                    }
                    if (MODE == 2 || MODE == 3) {
                        const u32x4 g = *(const u32x4*)(P + (size_t)row * NPROJ + gcol + col);
                        v0[0] *= sigmoidf_(bflo(g.x)); v0[1] *= sigmoidf_(bfhi(g.x)); v0[2] *= sigmoidf_(bflo(g.y)); v0[3] *= sigmoidf_(bfhi(g.y));
                        v1[0] *= sigmoidf_(bflo(g.z)); v1[1] *= sigmoidf_(bfhi(g.z)); v1[2] *= sigmoidf_(bflo(g.w)); v1[3] *= sigmoidf_(bfhi(g.w));
                    }
                    if (MODE == 3) {
                        const float* fp = F + (size_t)row * DM + col;
                        v0 += *(const f32x4*)fp; v1 += *(const f32x4*)(fp + 4);
                    }
                    if (MODE == 4) {
                        const int b = row / SEQ;
                        const float* gp = gate + (size_t)b * NMOD + col; const float* xp = X + (size_t)row * DM + col;
                        v0 = *(const f32x4*)xp + *(const f32x4*)gp * v0; v1 = *(const f32x4*)(xp + 4) + *(const f32x4*)(gp + 4) * v1;
                    }
                    if (MODE == 0 || MODE == 1 || MODE == 3) {
                        u32x4 w; w.x = cvt_pk_bf16(v0[0], v0[1]); w.y = cvt_pk_bf16(v0[2], v0[3]); w.z = cvt_pk_bf16(v1[0], v1[1]); w.w = cvt_pk_bf16(v1[2], v1[3]);
                        *(u32x4*)(O + (size_t)row * ldo + col) = w;
                    } else {
                        float* fp = F + (size_t)row * DM + col;
                        *(f32x4*)fp = v0; *(f32x4*)(fp + 4) = v1;
                    }
                }
            }
    }
};

template <class EpiT>
__device__ __forceinline__ void gemm_phase(LAS unsigned char* lds, const Gemm g, const StaticOrder& S, const EpiT& E) {
    const int tid = threadIdx.x, wid = __builtin_amdgcn_readfirstlane(tid >> 6), lane = tid & 63, wr = wid >> 2, wc = wid & 3, fr = lane & 15, fq = lane >> 4;
    const int K = g.K, nt = K / BK, lda = g.lda;
    unsigned voffA[2], voffB[2];
#pragma unroll
    for (int i = 0; i < 2; ++i) { int R, C; stage_rc(tid * 16 + i * 8192, R, C); const int Rb = (R & ~31) + perm32(R & 31);
        voffA[i] = (unsigned)(R * lda + C) * 2u; voffB[i] = (unsigned)(Rb * K + C) * 2u; }
    const size_t kstep = (size_t)(BK * 2);
    const size_t hstepA = (size_t)HALF * lda * 2, hstepB = (size_t)HALF * K * 2;
    const size_t tstepA = 2 * hstepA, tstepB = 2 * hstepB;
    const unsigned ldsw = (unsigned)wid * 1024u;
    const int aoff = lds_byte(wr * 64 + fr, fq * 8), boff = lds_byte(wc * 32 + fr, fq * 8);
#define PG8_SA(b, h) (((b) * 2 + (h)) * HTB)
#define PG8_SB(b, h) ((4 + (b) * 2 + (h)) * HTB)
#define PG8_STAGE(bufoff, gbase, voff) do { _Pragma("unroll") for (int _i = 0; _i < 2; ++_i) \
        __builtin_amdgcn_global_load_lds((const unsigned*)((const char*)(gbase) + (voff)[_i]), (LAS unsigned*)(lds + (bufoff) + ldsw + _i * 8192), 16, 0, 0); } while (0)
#define PG8_LDA(dst, b, h) do { _Pragma("unroll") for (int m = 0; m < 4; ++m) _Pragma("unroll") for (int k = 0; k < 2; ++k) dst[m][k] = *(const LAS bf16x8*)(lds + PG8_SA(b, h) + aoff + m * 2048 + k * 1024); } while (0)
#define PG8_LDB(dst, b, h) do { _Pragma("unroll") for (int n = 0; n < 2; ++n) _Pragma("unroll") for (int k = 0; k < 2; ++k) dst[n][k] = *(const LAS bf16x8*)(lds + PG8_SB(b, h) + boff + n * 2048 + k * 1024); } while (0)
#define PG8_MMA(ai, bj, At, Bt) do { __builtin_amdgcn_s_setprio(1); _Pragma("unroll") for (int m = 0; m < 4; ++m) _Pragma("unroll") for (int n = 0; n < 2; ++n) _Pragma("unroll") for (int k = 0; k < 2; ++k) \
        acc[ai][bj][m][n] = __builtin_amdgcn_mfma_f32_16x16x32_bf16(Bt[n][k], At[m][k], acc[ai][bj][m][n], 0, 0, 0); __builtin_amdgcn_s_setprio(0); } while (0)
#define PG8_WAIT_V(n) asm volatile("s_waitcnt vmcnt(" #n ")" ::: "memory")
#define PG8_WAIT_L(n) asm volatile("s_waitcnt lgkmcnt(" #n ")" ::: "memory")
#define PG8_BAR __builtin_amdgcn_s_barrier()
#define PG8_SCHED __builtin_amdgcn_sched_barrier(0)
    Unit cur, nxt; int ui = 0;
    if (!S.next(0, cur)) return;
    f32x4 acc[2][2][4][2];
#pragma unroll
    for (int a = 0; a < 2; ++a)
#pragma unroll
        for (int b = 0; b < 2; ++b)
#pragma unroll
            for (int m = 0; m < 4; ++m)
#pragma unroll
                for (int n = 0; n < 2; ++n) acc[a][b][m][n] = (f32x4){0.f, 0.f, 0.f, 0.f};
    bf16x8 At[4][2], B0[2][2], B1[2][2];
    const char* cA = (const char*)g.A + (size_t)cur.pm * tstepA; const char* cB = (const char*)g.Bt + (size_t)cur.pn * tstepB;
    PG8_STAGE(PG8_SB(0, 0), cB, voffB); PG8_STAGE(PG8_SB(0, 1), cB + hstepB, voffB); PG8_STAGE(PG8_SA(0, 0), cA, voffA); PG8_STAGE(PG8_SA(0, 1), cA + hstepA, voffA);
    if (wr == 1) PG8_BAR;
    PG8_WAIT_V(2); PG8_BAR;
    PG8_STAGE(PG8_SB(1, 0), cB + kstep, voffB); PG8_STAGE(PG8_SA(1, 0), cA + kstep, voffA); PG8_STAGE(PG8_SB(1, 1), cB + hstepB + kstep, voffB);
    PG8_WAIT_V(6); PG8_BAR;
    for (;;) {
        const bool has_next = S.next(ui + 1, nxt);
        const char* nA = has_next ? (const char*)g.A + (size_t)nxt.pm * tstepA : cA; const char* nB = has_next ? (const char*)g.Bt + (size_t)nxt.pn * tstepB : cB;
        for (int t = 0; t < nt; t += 2) {
            const bool last = (t == nt - 2);
            const char* a1 = cA + (size_t)(t + 1) * kstep;
            const char* a2 = last ? nA : cA + (size_t)(t + 2) * kstep; const char* b2 = last ? nB : cB + (size_t)(t + 2) * kstep;
            const char* a3 = a2 + kstep; const char* b3 = b2 + kstep;
            PG8_LDB(B0, 0, 0); PG8_LDB(B1, 0, 1); PG8_SCHED; PG8_LDA(At, 0, 0); PG8_STAGE(PG8_SA(1, 1), a1 + hstepA, voffA);
            PG8_WAIT_V(8); PG8_WAIT_L(0); PG8_BAR; PG8_MMA(0, 0, At, B0); PG8_MMA(0, 1, At, B1); PG8_BAR; PG8_SCHED;
            PG8_LDA(At, 0, 1); PG8_STAGE(PG8_SB(0, 0), b2, voffB); PG8_STAGE(PG8_SB(0, 1), b2 + hstepB, voffB); PG8_STAGE(PG8_SA(0, 0), a2, voffA);
            PG8_WAIT_V(8); PG8_WAIT_L(0); PG8_BAR; PG8_MMA(1, 0, At, B0); PG8_MMA(1, 1, At, B1); PG8_BAR; PG8_SCHED;
            PG8_LDB(B0, 1, 0); PG8_LDB(B1, 1, 1); PG8_SCHED; PG8_LDA(At, 1, 0); PG8_STAGE(PG8_SA(0, 1), a2 + hstepA, voffA);
            PG8_WAIT_V(8); PG8_WAIT_L(0); PG8_BAR; PG8_MMA(0, 0, At, B0); PG8_MMA(0, 1, At, B1); PG8_BAR; PG8_SCHED;
            PG8_LDA(At, 1, 1); PG8_STAGE(PG8_SB(1, 0), b3, voffB); PG8_STAGE(PG8_SB(1, 1), b3 + hstepB, voffB); PG8_STAGE(PG8_SA(1, 0), a3, voffA);
            PG8_WAIT_V(8); PG8_WAIT_L(0); PG8_BAR; PG8_MMA(1, 0, At, B0); PG8_MMA(1, 1, At, B1); PG8_BAR; PG8_SCHED;
        }
        if (wr == 0) PG8_BAR;
        E(acc, cur, wr, wc, fr, fq);
        if (!has_next) break;
#pragma unroll
        for (int a = 0; a < 2; ++a)
#pragma unroll
            for (int b = 0; b < 2; ++b)
#pragma unroll
                for (int m = 0; m < 4; ++m)
#pragma unroll
                    for (int n = 0; n < 2; ++n) acc[a][b][m][n] = (f32x4){0.f, 0.f, 0.f, 0.f};
        cur = nxt; cA = nA; cB = nB; ++ui;
        if (wr == 1) PG8_BAR;
    }
    PG8_WAIT_V(0);
    PG8_BAR;
#undef PG8_SA
#undef PG8_SB
#undef PG8_STAGE
#undef PG8_LDA
#undef PG8_LDB
#undef PG8_MMA
#undef PG8_WAIT_V
#undef PG8_WAIT_L
#undef PG8_BAR
#undef PG8_SCHED
}
}

struct Params { const float* in[25]; float* out; unsigned char* ws; int ph_lo, ph_hi; };
enum { I_X = 0, I_C, I_WADA, I_BADA, I_N1G, I_WIN, I_MU, I_WDU, I_DBASE, I_WIU, I_IBASE, I_WGU, I_KKS, I_KMIX, I_RBON, I_LNW, I_LNB, I_FBIAS, I_WOA, I_WOB, I_WOUT, I_N2G, I_WFF1, I_WFF2, I_FG };

__device__ __forceinline__ void transpose_item(const float* __restrict__ W, int K, int Nsrc, int nblk, bf16_t* WT, LAS float* scr, int item, int lane, bool map) {
    const int kb = item / nblk, nb = item % nblk, k0 = 64 * kb, n0 = 32 * nb;
    const int n = n0 + (lane & 31); const int sc = map ? win_src_col(n) : n;
#pragma unroll 8
    for (int i = 0; i < 32; ++i) { const int kk = 2 * i + (lane >> 5); scr[kk * 33 + (lane & 31)] = (sc >= 0) ? W[(size_t)(k0 + kk) * Nsrc + sc] : 0.f; }
    LDS_WAIT();
    const int c = lane & 7;
#pragma unroll
    for (int j = 0; j < 4; ++j) { const int nn = (lane >> 3) + 8 * j; const LAS float* s = scr + (8 * c) * 33 + nn;
        u32x4 o; o.x = pk2(s[0 * 33], s[1 * 33]); o.y = pk2(s[2 * 33], s[3 * 33]); o.z = pk2(s[4 * 33], s[5 * 33]); o.w = pk2(s[6 * 33], s[7 * 33]);
        *(u32x4*)(WT + (size_t)(n0 + nn) * K + k0 + 8 * c) = o; }
    LDS_WAIT();
}

__device__ __forceinline__ void phase_p0(const Params& p, LAS unsigned char* lds) {
    const int tid = threadIdx.x, lane = tid & 63, wave = tid >> 6;
    const int gw = blockIdx.x * NWAVES + wave, NGW = gridDim.x * NWAVES;
    LAS float* scr = (LAS float*)(lds + wave * 8448);
    LAS float* cact = (LAS float*)(lds + 73728);
    for (int i = tid; i < NB * DM; i += NTHREADS) { const int b = i >> 10, k = i & 1023; const float c = p.in[I_C][i]; cact[k * 8 + b] = c / (1.f + __expf(-c)); }
    __syncthreads();
    unsigned char* ws = p.ws;
    constexpr int I_1 = 16 * 176, I_2 = 8 * 32, I_3 = 8 * 32, I_4 = 16 * 32, I_5 = 16 * 128, I_6 = 64 * 32, I_7 = NMOD / 32;
    constexpr int NITEMS = I_1 + I_2 + I_3 + I_4 + I_5 + I_6 + I_7;
    for (int it = gw; it < NITEMS; it += NGW) {
        int r = it;
        if (r < I_7) {
            const int col = 32 * r + (lane & 31), kh = lane >> 5;
            float acc[8];
#pragma unroll
            for (int b = 0; b < 8; ++b) acc[b] = 0.f;
            const float* wp = p.in[I_WADA] + col;
#pragma unroll 4
            for (int k = kh * 512; k < kh * 512 + 512; ++k) {
                const float wv = wp[(size_t)k * NMOD];
                const f32x4 c0 = *(const LAS f32x4*)(cact + k * 8), c1 = *(const LAS f32x4*)(cact + k * 8 + 4);
                acc[0] += c0[0] * wv; acc[1] += c0[1] * wv; acc[2] += c0[2] * wv; acc[3] += c0[3] * wv;
                acc[4] += c1[0] * wv; acc[5] += c1[1] * wv; acc[6] += c1[2] * wv; acc[7] += c1[3] * wv;
            }
            float* mod = (float*)(ws + WS_MOD);
            const float bias = p.in[I_BADA][col];
#pragma unroll
            for (int b = 0; b < 8; ++b) { const float s = acc[b] + __shfl_xor(acc[b], 32); if (kh == 0) mod[b * NMOD + col] = s + bias; }
            continue;
        }
        r -= I_7;
        if (r < I_1) { transpose_item(p.in[I_WIN], DM, N_IN, NPROJ / 32, (bf16_t*)(ws + WS_WIN), scr, r, lane, true); continue; } r -= I_1;
        if (r < I_2) { transpose_item(p.in[I_WOA], RW, DM, DM / 32, (bf16_t*)(ws + WS_WOA), scr, r, lane, false); continue; } r -= I_2;
        if (r < I_3) { transpose_item(p.in[I_WOB], RW, DM, DM / 32, (bf16_t*)(ws + WS_WOB), scr, r, lane, false); continue; } r -= I_3;
        if (r < I_4) { transpose_item(p.in[I_WOUT], DM, DM, DM / 32, (bf16_t*)(ws + WS_WOUT), scr, r, lane, false); continue; } r -= I_4;
        if (r < I_5) { transpose_item(p.in[I_WFF1], DM, DFF, DFF / 32, (bf16_t*)(ws + WS_WFF1), scr, r, lane, false); continue; } r -= I_5;
        transpose_item(p.in[I_WFF2], DFF, DM, DM / 32, (bf16_t*)(ws + WS_WFF2), scr, r, lane, false);
    }
}

template <int MODE>
__device__ __forceinline__ void phase_norm(const float* X, const float* g, const float* mod, int shoff, int scoff, bf16_t* Hout, float* Fout) {
    const int tid = threadIdx.x, lane = tid & 63, wave = tid >> 6;
    const int gw = blockIdx.x * NWAVES + wave, NGW = gridDim.x * NWAVES;
    for (int m = gw; m < T; m += NGW) {
        const f32x4* xr = (const f32x4*)(X + (size_t)m * DM) + lane;
        f32x4 v[4]; float s = 0.f;
#pragma unroll
        for (int j = 0; j < 4; ++j) { v[j] = xr[64 * j]; s += (v[j].x * v[j].x + v[j].y * v[j].y) + (v[j].z * v[j].z + v[j].w * v[j].w); }
        const float rstd = rsqrtf(wave_sum(s) * (1.f / DM) + NORM_EPS);
        const int b = m / SEQ;
#pragma unroll
        for (int j = 0; j < 4; ++j) {
            const int col = 4 * lane + 256 * j;
            const f32x4 g4 = *(const f32x4*)(g + col);
            f32x4 y = v[j] * rstd * g4;
            if (MODE == 0) {
                const f32x4 sc = *(const f32x4*)(mod + (size_t)b * NMOD + scoff + col), sh = *(const f32x4*)(mod + (size_t)b * NMOD + shoff + col);
                y = y * (sc + 1.f) + sh;
                u32x2 o; o.x = pk2(y.x, y.y); o.y = pk2(y.z, y.w);
                *(u32x2*)(Hout + (size_t)m * DM + col) = o;
            } else {
                *(f32x4*)(Fout + (size_t)m * DM + col) = y;
            }
        }
    }
}

__device__ __forceinline__ float logsigmoidf_(float x) { return fminf(x, 0.f) - log1pf(__expf(-fabsf(x))); }

__device__ __forceinline__ void phase_prep(const Params& p, LAS unsigned char* lds) {
    const int tid = threadIdx.x, lane = tid & 63, wave = tid >> 6;
    LAS float* inb = (LAS float*)lds;
    unsigned char* ws = p.ws;
    const bf16_t* PROJ = (const bf16_t*)(ws + WS_PROJ);
    bf16_t* Rb = (bf16_t*)p.out; bf16_t* Kb = Rb + (size_t)T * RW; bf16_t* Vb = Kb + (size_t)T * RW; bf16_t* Ab = Vb + (size_t)T * RW;
    bf16_t* Bb = (bf16_t*)(ws + WS_B); _Float16* Wb = (_Float16*)(ws + WS_W16); bf16_t* Gb = (bf16_t*)(ws + WS_G);
    const float* mu = p.in[I_MU];
    const int c = tid;
    for (int tile = blockIdx.x; tile < T / 32; tile += gridDim.x) {
        const int t0 = tile * 32;
        {   const int cc = tid & 255, nc = C_WD + cc; const float muv = mu[win_src_col(nc)];
#pragma unroll 4
            for (int i = 0; i < 16; ++i) {
                const int tt = (tid >> 8) + 2 * i, t = t0 + tt;
                const float cur = bf2f(PROJ[(size_t)t * NPROJ + nc]);
                const float prev = (t % SEQ == 0) ? 0.f : bf2f(PROJ[(size_t)(t - 1) * NPROJ + nc]);
                const float pv = cur + muv * (prev - cur);
                const float val = (cc < 64) ? tanhf(pv) : ((cc < 128) ? pv : sigmoidf_(pv));
                inb[cc * 36 + tt] = val;
            }
        }
        __syncthreads();
        float acc[32], av[32];
#pragma unroll
        for (int i = 0; i < 32; ++i) acc[i] = 0.f;
        {   const float* wp = p.in[I_WDU] + c;
#pragma unroll 2
            for (int j = 0; j < 64; ++j) { const float wv = wp[j * RW];
#pragma unroll
                for (int q = 0; q < 8; ++q) { const f32x4 iv = *(const LAS f32x4*)(inb + j * 36 + 4 * q); acc[4 * q] += iv[0] * wv; acc[4 * q + 1] += iv[1] * wv; acc[4 * q + 2] += iv[2] * wv; acc[4 * q + 3] += iv[3] * wv; } }
            const float base = p.in[I_DBASE][c];
#pragma unroll
            for (int i = 0; i < 32; ++i) { const float u = 0.6065306597f * sigmoidf_(base + acc[i]); Wb[(size_t)(t0 + i) * RW + c] = (_Float16)u; }
        }
#pragma unroll
        for (int i = 0; i < 32; ++i) acc[i] = 0.f;
        {   const float* wp = p.in[I_WIU] + c;
#pragma unroll 2
            for (int j = 0; j < 64; ++j) { const float wv = wp[j * RW];
#pragma unroll
                for (int q = 0; q < 8; ++q) { const f32x4 iv = *(const LAS f32x4*)(inb + (64 + j) * 36 + 4 * q); acc[4 * q] += iv[0] * wv; acc[4 * q + 1] += iv[1] * wv; acc[4 * q + 2] += iv[2] * wv; acc[4 * q + 3] += iv[3] * wv; } }
            const float base = p.in[I_IBASE][c];
#pragma unroll
            for (int i = 0; i < 32; ++i) av[i] = sigmoidf_(base + acc[i]);
        }
#pragma unroll
        for (int i = 0; i < 32; ++i) acc[i] = 0.f;
        {   const float* wp = p.in[I_WGU] + c;
#pragma unroll 2
            for (int j = 0; j < 128; ++j) { const float wv = wp[j * RW];
#pragma unroll
                for (int q = 0; q < 8; ++q) { const f32x4 iv = *(const LAS f32x4*)(inb + (128 + j) * 36 + 4 * q); acc[4 * q] += iv[0] * wv; acc[4 * q + 1] += iv[1] * wv; acc[4 * q + 2] += iv[2] * wv; acc[4 * q + 3] += iv[3] * wv; } }
#pragma unroll
            for (int i = 0; i < 32; ++i) Gb[(size_t)(t0 + i) * RW + c] = (bf16_t)f2bf(acc[i]);
        }
        {   const float mur = mu[c], muk = mu[576 + c], muvv = mu[1088 + c], kks = p.in[I_KKS][c], mix = p.in[I_KMIX][c];
#pragma unroll
            for (int i = 0; i < 32; ++i) {
                const int t = t0 + i; const bool first = (t % SEQ == 0);
                const bf16_t* row = PROJ + (size_t)t * NPROJ; const bf16_t* prow = row - NPROJ;
                const float rc = bf2f(row[C_R + c]), kc = bf2f(row[C_K + c]), vc = bf2f(row[C_V + c]);
                const float rp = first ? 0.f : bf2f(prow[C_R + c]), kp = first ? 0.f : bf2f(prow[C_K + c]), vp = first ? 0.f : bf2f(prow[C_V + c]);
                const float r = rc + mur * (rp - rc), k = kc + muk * (kp - kc), v = vc + muvv * (vp - vc);
                float kk = k * kks; const float ss = wave_sum(kk * kk);
                kk = kk / fmaxf(sqrtf(ss), 1e-12f);
                const float a = av[i];
                const size_t o = (size_t)t * RW + c;
                Rb[o] = (bf16_t)f2bf(r); Kb[o] = (bf16_t)f2bf(k * (1.f + (a - 1.f) * mix)); Vb[o] = (bf16_t)f2bf(v);
                Ab[o] = (bf16_t)f2bf(-kk); Bb[o] = (bf16_t)f2bf(kk * a);
            }
        }
        __syncthreads();
    }
    if (wave == 0) {
        float* CUM = (float*)(ws + WS_CUM);
        for (int bh = blockIdx.x; bh < NB * NH; bh += gridDim.x) {
            const int b = bh >> 3, h = bh & 7; const float fb = p.in[I_FBIAS][h];
            const bf16_t* src = PROJ + (size_t)(b * SEQ + lane * 64) * NPROJ + C_FL + h;
            float loc = 0.f;
#pragma unroll 8
            for (int i = 0; i < 64; ++i) loc += logsigmoidf_(bf2f(src[(size_t)i * NPROJ]) + fb);
            float inc = loc;
#pragma unroll
            for (int o = 1; o < 64; o <<= 1) { const float n = __shfl_up(inc, o); if (lane >= o) inc += n; }
            float run = inc - loc;
            float* dst = CUM + (size_t)bh * SEQ + lane * 64;
#pragma unroll 8
            for (int i = 0; i < 64; ++i) { run += logsigmoidf_(bf2f(src[(size_t)i * NPROJ]) + fb); dst[i] = run; }
        }
    }
}

template <int CTRL> __device__ __forceinline__ float dppf(float v) { return __builtin_bit_cast(float, __builtin_amdgcn_update_dpp(0, __builtin_bit_cast(int, v), CTRL, 0xf, 0xf, false)); }
__device__ __forceinline__ float row16_sum(float v) { v += dppf<0x128>(v); v += dppf<0x124>(v); v += dppf<0x122>(v); v += dppf<0x121>(v); return v; }

__device__ __forceinline__ void phase_scan(const Params& p, LAS unsigned char* lds) {
    constexpr int CS = 32, SF = 336, NCH = SEQ / CS;
    const int tid = threadIdx.x, lane = tid & 63, wave = __builtin_amdgcn_readfirstlane(tid >> 6);
    LAS float* buf = (LAS float*)lds;
    LAS float* ybuf = buf + 2 * CS * SF;
    unsigned char* ws = p.ws;
    const bf16_t* Rb = (const bf16_t*)p.out; const bf16_t* Kb = Rb + (size_t)T * RW; const bf16_t* Vb = Kb + (size_t)T * RW; const bf16_t* Ab = Vb + (size_t)T * RW;
    const bf16_t* Bb = (const bf16_t*)(ws + WS_B); const _Float16* Wb = (const _Float16*)(ws + WS_W16);
    unsigned char* Yb = ws + WS_PROJ;
    for (int item = blockIdx.x; item < 256; item += gridDim.x) {
        const int bh = item & 63, rg = item >> 6, b = bh >> 3, h = bh & 7;
        const size_t rowbase = (size_t)b * SEQ; const int colbase = h * 64;
        const int pt = tid - 256, pstep = pt >> 3, c8 = (pt & 7) * 8, i2 = (pt & 7) * 2;
        u32x4 la, lb, lk, lr, lw; unsigned lv;
#define SCAN_LOAD(ch) do { const size_t o = (rowbase + (size_t)(ch) * CS + pstep) * RW + colbase; \
            la = *(const u32x4*)(Ab + o + c8); lb = *(const u32x4*)(Bb + o + c8); lk = *(const u32x4*)(Kb + o + c8); lr = *(const u32x4*)(Rb + o + c8); \
            lw = *(const u32x4*)(Wb + o + c8); lv = *(const unsigned*)(Vb + o + rg * 16 + i2); } while (0)
#define SCAN_ST8(dst, v) do { *(LAS f32x4*)(dst) = (f32x4){bflo((v).x), bfhi((v).x), bflo((v).y), bfhi((v).y)}; *(LAS f32x4*)((dst) + 4) = (f32x4){bflo((v).z), bfhi((v).z), bflo((v).w), bfhi((v).w)}; } while (0)
#define SCAN_WRITE(cb) do { LAS float* d = buf + ((cb) * CS + pstep) * SF; \
            { f32x4 w0, w1; const _Float16* hp = (const _Float16*)&lw; \
              w0[0] = __expf(-(float)hp[0]); w0[1] = __expf(-(float)hp[1]); w0[2] = __expf(-(float)hp[2]); w0[3] = __expf(-(float)hp[3]); \
              w1[0] = __expf(-(float)hp[4]); w1[1] = __expf(-(float)hp[5]); w1[2] = __expf(-(float)hp[6]); w1[3] = __expf(-(float)hp[7]); \
              *(LAS f32x4*)(d + c8) = w0; *(LAS f32x4*)(d + c8 + 4) = w1; } \
            SCAN_ST8(d + 64 + c8, la); SCAN_ST8(d + 128 + c8, lb); SCAN_ST8(d + 192 + c8, lk); SCAN_ST8(d + 256 + c8, lr); \
            *(LAS f32x2*)(d + 320 + i2) = (f32x2){bflo(lv), bfhi(lv)}; } while (0)
#define SCAN_YOUT(ch, cb) do { const f32x2 yv = *(const LAS f32x2*)(ybuf + ((cb) * CS + pstep) * 16 + i2); \
            *(f32x2*)(Yb + (rowbase + (size_t)(ch) * CS + pstep) * (size_t)(NPROJ * 2) + (size_t)(colbase + rg * 16 + i2) * 4) = yv; } while (0)
        if (wave >= 4) { SCAN_LOAD(0); SCAN_WRITE(0); }
        __syncthreads();
        const int rr = lane >> 4, cgp = lane & 15, irow = wave * 4 + rr;
        f32x4 s = {0.f, 0.f, 0.f, 0.f};
        for (int ch = 0; ch < NCH; ++ch) {
            const int cb = ch & 1;
            if (wave >= 4) {
                if (ch + 1 < NCH) SCAN_LOAD(ch + 1);
                if (ch > 0) SCAN_YOUT(ch - 1, cb ^ 1);
                if (ch + 1 < NCH) SCAN_WRITE(cb ^ 1);
            } else {
                const LAS float* bp = buf + cb * CS * SF + 4 * cgp;
                LAS float* yp = ybuf + cb * CS * 16 + irow;
#pragma unroll 4
                for (int st = 0; st < CS; ++st) {
                    const LAS float* q = bp + st * SF;
                    const f32x4 w4 = *(const LAS f32x4*)q, a4 = *(const LAS f32x4*)(q + 64), b4 = *(const LAS f32x4*)(q + 128), k4 = *(const LAS f32x4*)(q + 192), r4 = *(const LAS f32x4*)(q + 256);
                    const float v = bp[st * SF + 320 - 4 * cgp + irow];
                    const float dot = (s[0] * a4[0] + s[1] * a4[1]) + (s[2] * a4[2] + s[3] * a4[3]);
                    const f32x4 pre = s * w4 + k4 * v;
                    const float sa = row16_sum(dot);
                    s = pre + b4 * sa;
                    const float yd = (s[0] * r4[0] + s[1] * r4[1]) + (s[2] * r4[2] + s[3] * r4[3]);
                    const float y = row16_sum(yd);
                    if (cgp == 0) yp[st * 16] = y;
                }
            }
            __syncthreads();
        }
        if (wave >= 4) SCAN_YOUT(NCH - 1, (NCH - 1) & 1);
        __syncthreads();
#undef SCAN_LOAD
#undef SCAN_ST8
#undef SCAN_WRITE
#undef SCAN_YOUT
    }
}

__device__ __forceinline__ int crow(int r, int hi) { return (r & 3) + 8 * (r >> 2) + 4 * hi; }

__device__ __forceinline__ void attn_unit(const Params& p, LAS unsigned char* lds, int b, int h, int qb) {
    constexpr int BUFB = 18688, KOFF = 0, VOFF = 9216, BOFF = 18432;
    constexpr float C2 = 0.125f * LOG2E;
    const int tid = threadIdx.x, lane = tid & 63, wave = __builtin_amdgcn_readfirstlane(tid >> 6), r32 = lane & 31, hi = lane >> 5;
    bf16_t* PROJ = (bf16_t*)(p.ws + WS_PROJ);
    const float* cumg = (const float*)(p.ws + WS_CUM) + (size_t)(b * NH + h) * SEQ;
    const size_t rowbase = (size_t)b * SEQ; const int q0 = qb * 256, qw = q0 + wave * 32;
    LAS float* wsf = (LAS float*)(lds + 2 * BUFB) + wave * 32;
    bf16x8 qr[4];
    {   const bf16_t* Qp = PROJ + (rowbase + qw + r32) * NPROJ + C_FQ + h * 64;
#pragma unroll
        for (int d0 = 0; d0 < 4; ++d0) qr[d0] = *(const bf16x8*)(Qp + d0 * 16 + hi * 8); }
    const bf16_t* Kg = PROJ + rowbase * NPROJ + C_FK + h * 64; const bf16_t* Vg = PROJ + rowbase * NPROJ + C_FV + h * 64;
    const int NT = (q0 + 256) / 64;
    const int lkey = tid >> 3, d8 = (tid & 7) * 8;
    u32x4 kreg, vreg; float kbreg = 0.f;
#define ATT_LOAD(kt) do { const size_t o = (size_t)((kt) * 64 + lkey) * NPROJ + d8; kreg = *(const u32x4*)(Kg + o); vreg = *(const u32x4*)(Vg + o); if (tid < 64) kbreg = -cumg[(kt) * 64 + tid] * LOG2E; } while (0)
#define ATT_WRITE(cb) do { LAS unsigned char* B_ = lds + (cb) * BUFB; *(LAS u32x4*)(B_ + KOFF + lkey * 144 + d8 * 2) = kreg; \
        LAS bf16_t* vt = (LAS bf16_t*)(B_ + VOFF) + d8 * 72 + lkey; \
        vt[0] = (bf16_t)(vreg.x & 0xffffu); vt[72] = (bf16_t)(vreg.x >> 16); vt[144] = (bf16_t)(vreg.y & 0xffffu); vt[216] = (bf16_t)(vreg.y >> 16); \
        vt[288] = (bf16_t)(vreg.z & 0xffffu); vt[360] = (bf16_t)(vreg.z >> 16); vt[432] = (bf16_t)(vreg.w & 0xffffu); vt[504] = (bf16_t)(vreg.w >> 16); \
        if (tid < 64) ((LAS float*)(B_ + BOFF))[tid] = kbreg; } while (0)
    ATT_LOAD(0); ATT_WRITE(0);
    __syncthreads();
    float m = -1e30f, l = 0.f; f32x16 o[2];
#pragma unroll
    for (int r = 0; r < 16; ++r) { o[0][r] = 0.f; o[1][r] = 0.f; }
    for (int kt = 0; kt < NT; ++kt) {
        const int cb = kt & 1;
        if (kt + 1 < NT) ATT_LOAD(kt + 1);
        if (kt * 64 <= qw + 31) {
            const LAS unsigned char* Bf = lds + cb * BUFB;
            f32x16 p0, p1;
#pragma unroll
            for (int r = 0; r < 16; ++r) { p0[r] = 0.f; p1[r] = 0.f; }
#pragma unroll
            for (int d0 = 0; d0 < 4; ++d0) {
                const bf16x8 ka0 = *(const LAS bf16x8*)(Bf + KOFF + r32 * 144 + (d0 * 16 + hi * 8) * 2);
                const bf16x8 ka1 = *(const LAS bf16x8*)(Bf + KOFF + (32 + r32) * 144 + (d0 * 16 + hi * 8) * 2);
                p0 = __builtin_amdgcn_mfma_f32_32x32x16_bf16(ka0, qr[d0], p0, 0, 0, 0);
                p1 = __builtin_amdgcn_mfma_f32_32x32x16_bf16(ka1, qr[d0], p1, 0, 0, 0);
            }
            const LAS float* kbp = (const LAS float*)(Bf + BOFF);
#pragma unroll
            for (int g = 0; g < 4; ++g) {
                const f32x4 kb0 = *(const LAS f32x4*)(kbp + 8 * g + 4 * hi), kb1 = *(const LAS f32x4*)(kbp + 32 + 8 * g + 4 * hi);
#pragma unroll
                for (int j = 0; j < 4; ++j) { p0[4 * g + j] = p0[4 * g + j] * C2 + kb0[j]; p1[4 * g + j] = p1[4 * g + j] * C2 + kb1[j]; }
            }
            if (kt * 64 + 63 > qw) {
                const int qabs = qw + r32;
#pragma unroll
                for (int r = 0; r < 16; ++r) { const int key = kt * 64 + crow(r, hi); if (key > qabs) p0[r] = -INFINITY; if (key + 32 > qabs) p1[r] = -INFINITY; }
            }
            float rm = fmaxf(p0[0], p1[0]);
#pragma unroll
            for (int r = 1; r < 16; ++r) rm = fmaxf(rm, fmaxf(p0[r], p1[r]));
            rm = fmaxf(rm, __shfl_xor(rm, 32));
            const float mnew = fmaxf(m, rm), alpha = exp2f(m - mnew); m = mnew;
            float rs = 0.f;
#pragma unroll
            for (int r = 0; r < 16; ++r) { p0[r] = exp2f(p0[r] - mnew); p1[r] = exp2f(p1[r] - mnew); rs += p0[r] + p1[r]; }
            l = l * alpha + rs;
            if (hi == 0) wsf[r32] = alpha;
            LDS_WAIT();
#pragma unroll
            for (int g = 0; g < 4; ++g) { const f32x4 al = *(const LAS f32x4*)(wsf + 8 * g + 4 * hi);
#pragma unroll
                for (int j = 0; j < 4; ++j) { o[0][4 * g + j] *= al[j]; o[1][4 * g + j] *= al[j]; } }
            u32x4 pw[4];
            pw[0] = (u32x4){pk2(p0[0], p0[1]), pk2(p0[2], p0[3]), pk2(p0[4], p0[5]), pk2(p0[6], p0[7])};
            pw[1] = (u32x4){pk2(p0[8], p0[9]), pk2(p0[10], p0[11]), pk2(p0[12], p0[13]), pk2(p0[14], p0[15])};
            pw[2] = (u32x4){pk2(p1[0], p1[1]), pk2(p1[2], p1[3]), pk2(p1[4], p1[5]), pk2(p1[6], p1[7])};
            pw[3] = (u32x4){pk2(p1[8], p1[9]), pk2(p1[10], p1[11]), pk2(p1[12], p1[13]), pk2(p1[14], p1[15])};
#pragma unroll
            for (int d0 = 0; d0 < 2; ++d0)
#pragma unroll
                for (int sl = 0; sl < 4; ++sl) {
                    const int base = 32 * (sl >> 1) + 16 * (sl & 1) + 4 * hi;
                    const LAS unsigned char* vp = Bf + VOFF + (d0 * 32 + r32) * 144 + base * 2;
                    const u32x2 lo = *(const LAS u32x2*)vp, hh = *(const LAS u32x2*)(vp + 16);
                    const u32x4 vv = {lo.x, lo.y, hh.x, hh.y};
                    o[d0] = __builtin_amdgcn_mfma_f32_32x32x16_bf16(__builtin_bit_cast(bf16x8, pw[sl]), __builtin_bit_cast(bf16x8, vv), o[d0], 0, 0, 0);
                }
        }
        if (kt + 1 < NT) ATT_WRITE(cb ^ 1);
        __syncthreads();
    }
#undef ATT_LOAD
#undef ATT_WRITE
    l += __shfl_xor(l, 32);
    if (hi == 0) wsf[r32] = 1.f / l;
    LDS_WAIT();
    bf16_t* Op = PROJ + (rowbase + qw) * NPROJ + C_FQ + h * 64 + r32;
#pragma unroll
    for (int g = 0; g < 4; ++g) { const f32x4 rl = *(const LAS f32x4*)(wsf + 8 * g + 4 * hi);
#pragma unroll
        for (int j = 0; j < 4; ++j) { const int r = 4 * g + j; bf16_t* orow = Op + (size_t)crow(r, hi) * NPROJ;
            orow[0] = (bf16_t)f2bf(o[0][r] * rl[j]); orow[32] = (bf16_t)f2bf(o[1][r] * rl[j]); } }
    LDS_WAIT();
}

__device__ __forceinline__ void phase_attn(const Params& p, LAS unsigned char* lds) {
    for (int vb = blockIdx.x; vb < 256; vb += gridDim.x) {
        const int bh = vb >> 2, sub = vb & 3, b = bh >> 3, h = bh & 7;
        for (int ui = 0; ui < 4; ++ui) {
            const int qb = (ui == 0) ? sub : (ui == 1) ? 7 - sub : (ui == 2) ? 8 + sub : 15 - sub;
            attn_unit(p, lds, b, h, qb);
        }
    }
}

__device__ __forceinline__ void phase_fin(const Params& p) {
    const int tid = threadIdx.x, lane = tid & 63, wave = tid >> 6;
    const int gw = blockIdx.x * NWAVES + wave, NGW = gridDim.x * NWAVES;
    unsigned char* ws = p.ws;
    const bf16_t* Rb = (const bf16_t*)p.out; const bf16_t* Kb = Rb + (size_t)T * RW; const bf16_t* Vb = Kb + (size_t)T * RW;
    const bf16_t* Gb = (const bf16_t*)(ws + WS_G);
    unsigned char* PROJb = ws + WS_PROJ;
    for (int it = gw; it < T * NH; it += NGW) {
        const int t = it >> 3, h = it & 7, c = h * 64 + lane;
        const float y = *(const float*)(PROJb + (size_t)t * (NPROJ * 2) + (size_t)c * 4);
        const float mean = wave_sum(y) * (1.f / 64.f); const float d = y - mean;
        const float var = wave_sum(d * d) * (1.f / 64.f);
        const float yn = d * rsqrtf(var + GN_EPS) * p.in[I_LNW][c] + p.in[I_LNB][c];
        const size_t o = (size_t)t * RW + c;
        const float r = bf2f(Rb[o]), k = bf2f(Kb[o]), v = bf2f(Vb[o]), g = bf2f(Gb[o]);
        const float bon = wave_sum(r * k * p.in[I_RBON][c]) * v;
        ((bf16_t*)PROJb)[(size_t)t * NPROJ + C_V + c] = (bf16_t)f2bf((yn + bon) * g);
    }
}

__global__ void __launch_bounds__(NTHREADS, 2) fwd_kernel(Params p) {
    extern __shared__ __attribute__((aligned(16))) unsigned char lds_raw[];
    LAS unsigned char* lds = (LAS unsigned char*)lds_raw;
    cg::grid_group grid = cg::this_grid();
    const int lo = p.ph_lo, hi = p.ph_hi;
    unsigned char* ws = p.ws;
    float* mod = (float*)(ws + WS_MOD);
    bf16_t* PROJ = (bf16_t*)(ws + WS_PROJ);
    const int G = gridDim.x, bx = blockIdx.x;
#define IN(k) (lo <= (k) && (k) < hi)
#define SEAM(k) do { if (IN(k) && IN((k) + 1)) grid.sync(); } while (0)
    if (IN(0)) { phase_p0(p, lds); } SEAM(0);
    if (IN(1)) { phase_norm<0>(p.in[I_X], p.in[I_N1G], mod, 0, 1024, (bf16_t*)(ws + WS_H), nullptr); } SEAM(1);
    if (IN(2)) {
        pg8::Gemm g{(const bf16_t*)(ws + WS_H), (const bf16_t*)(ws + WS_WIN), T, NPROJ, DM, DM}; pg8::StaticOrder S; S.init(T, NPROJ, G, bx);
        pg8::Epi<0> E{PROJ, NPROJ, nullptr, nullptr, nullptr, nullptr, 0};
        pg8::gemm_phase(lds, g, S, E);
    } SEAM(2);
    if (IN(3)) { phase_prep(p, lds); } SEAM(3);
    if (IN(4)) { phase_scan(p, lds); }
    if (IN(5)) { __syncthreads(); phase_attn(p, lds); } SEAM(5);
    if (IN(6)) { phase_fin(p); } SEAM(6);
    if (IN(7)) {
        {   pg8::Gemm g{PROJ + C_V, (const bf16_t*)(ws + WS_WOA), T, DM, RW, NPROJ}; pg8::StaticOrder S; S.init(T, DM, G, bx);
            pg8::Epi<2> E{nullptr, 0, p.out, nullptr, nullptr, PROJ, C_GA};
            pg8::gemm_phase(lds, g, S, E); }
        {   pg8::Gemm g{PROJ + C_FQ, (const bf16_t*)(ws + WS_WOB), T, DM, RW, NPROJ}; pg8::StaticOrder S; S.init(T, DM, G, bx);
            pg8::Epi<3> E{(bf16_t*)(ws + WS_H), DM, p.out, nullptr, nullptr, PROJ, C_GB};
            pg8::gemm_phase(lds, g, S, E); }
    } SEAM(7);
    if (IN(8)) {
        pg8::Gemm g{(const bf16_t*)(ws + WS_H), (const bf16_t*)(ws + WS_WOUT), T, DM, DM, DM}; pg8::StaticOrder S; S.init(T, DM, G, bx);
        pg8::Epi<4> E{nullptr, 0, p.out, p.in[I_X], mod + 2048, nullptr, 0};
        pg8::gemm_phase(lds, g, S, E);
    } SEAM(8);
    if (IN(9)) { phase_norm<0>(p.out, p.in[I_N2G], mod, 3072, 4096, (bf16_t*)(ws + WS_H), nullptr); } SEAM(9);
    if (IN(10)) {
        pg8::Gemm g{(const bf16_t*)(ws + WS_H), (const bf16_t*)(ws + WS_WFF1), T, DFF, DM, DM}; pg8::StaticOrder S; S.init(T, DFF, G, bx);
        pg8::Epi<1> E{PROJ, DFF, nullptr, nullptr, nullptr, nullptr, 0};
        pg8::gemm_phase(lds, g, S, E);
    } SEAM(10);
    if (IN(11)) {
        pg8::Gemm g{PROJ, (const bf16_t*)(ws + WS_WFF2), T, DM, DFF, DFF}; pg8::StaticOrder S; S.init(T, DM, G, bx);
        pg8::Epi<4> E{nullptr, 0, p.out, p.out, mod + 5120, nullptr, 0};
        pg8::gemm_phase(lds, g, S, E);
    } SEAM(11);
    if (IN(12)) { phase_norm<1>(p.out, p.in[I_FG], nullptr, 0, 0, nullptr, p.out); }
#undef IN
#undef SEAM
}

extern "C" void kernel_launch(void* const* d_in, const int* in_sizes, int n_in, void* d_out, int out_size, void* d_ws, size_t ws_size, hipStream_t stream) {
    static int grid = 0;
    if (grid == 0) {
        if (n_in != 25 || out_size != T * DM || ws_size < WS_END) { fprintf(stderr, "kernel_launch: unexpected shapes (n_in %d out %d ws %zu)\n", n_in, out_size, ws_size); grid = -1; return; }
        int dev = 0, cus = 0, per_cu = 0;
        hipGetDevice(&dev);
        hipDeviceGetAttribute(&cus, hipDeviceAttributeMultiprocessorCount, dev);
        if (hipFuncSetAttribute((const void*)fwd_kernel, hipFuncAttributeMaxDynamicSharedMemorySize, LDS_BYTES) != hipSuccess) { fprintf(stderr, "kernel_launch: hipFuncSetAttribute failed\n"); grid = -1; return; }
        if (hipOccupancyMaxActiveBlocksPerMultiprocessor(&per_cu, (const void*)fwd_kernel, NTHREADS, LDS_BYTES) != hipSuccess || per_cu < 1) { fprintf(stderr, "kernel_launch: occupancy query failed (%d)\n", per_cu); (void)hipGetLastError(); per_cu = 1; }
        grid = cus * (per_cu > 1 ? 1 : per_cu);
        fprintf(stderr, "kernel_launch: grid %d (cus %d, per_cu %d)\n", grid, cus, per_cu);
    }
    if (grid < 0) return;
    Params p{};
    for (int i = 0; i < 25; ++i) p.in[i] = (const float*)d_in[i];
    p.out = (float*)d_out; p.ws = (unsigned char*)d_ws;
#if N_LAUNCH_MODE == 0
    p.ph_lo = 0; p.ph_hi = NPHASE;
    void* args[] = {&p};
    hipError_t e = hipLaunchCooperativeKernel((const void*)fwd_kernel, dim3(grid), dim3(NTHREADS), args, LDS_BYTES, stream);
    if (e != hipSuccess) fprintf(stderr, "cooperative launch failed: %s (grid %d)\n", hipGetErrorString(e), grid);
#else
    for (int ph = 0; ph < NPHASE; ++ph) {
        if (ph == 5) continue;
        p.ph_lo = ph; p.ph_hi = (ph == 4) ? 6 : ph + 1;
        hipLaunchKernelGGL(fwd_kernel, dim3(grid), dim3(NTHREADS), LDS_BYTES, stream, p);
    }
#endif
}
```

```cpp
#include <hip/hip_runtime.h>
#include <hip/hip_cooperative_groups.h>
#include <cstdio>
#include <cstdint>
namespace cg = cooperative_groups;

#ifndef N_LAUNCH_MODE
#define N_LAUNCH_MODE 0
#endif

#define LAS __attribute__((address_space(3)))
typedef unsigned short bf16_t;
typedef short bf16x8 __attribute__((ext_vector_type(8)));
typedef float f32x4 __attribute__((ext_vector_type(4)));
typedef float f32x2 __attribute__((ext_vector_type(2)));
typedef float f32x16 __attribute__((ext_vector_type(16)));
typedef unsigned u32x4 __attribute__((ext_vector_type(4)));
typedef unsigned u32x2 __attribute__((ext_vector_type(2)));

constexpr int NB = 8, SEQ = 4096, DM = 1024, T = NB * SEQ, NH = 8, HD = 64, RW = 512, DFF = 4096, NMOD = 6144;
constexpr int N_IN = 5384, NPROJ = 5632;
constexpr int C_R = 0, C_K = 512, C_V = 1024, C_WD = 1536, C_AD = 1600, C_GD = 1664, C_FQ = 1792, C_FK = 2304, C_FV = 2816, C_GA = 3328, C_GB = 4352, C_FL = 5376;
constexpr float NORM_EPS = 1e-6f, GN_EPS = 64e-5f, LOG2E = 1.4426950408889634f;
constexpr int NWAVES = 8, NTHREADS = 512, LDS_BYTES = 135168;
constexpr int NPHASE = 13;

constexpr size_t MiB = 1u << 20;
constexpr size_t WS_WIN = 0, WS_WOA = 11 * MiB, WS_WOB = 12 * MiB, WS_WOUT = 13 * MiB, WS_WFF1 = 15 * MiB, WS_WFF2 = 23 * MiB;
constexpr size_t WS_MOD = 31 * MiB, WS_CUM = 32 * MiB;
constexpr size_t WS_H = 36 * MiB;
constexpr size_t WS_B = 36 * MiB, WS_W16 = 68 * MiB;
constexpr size_t WS_PROJ = 100 * MiB;
constexpr size_t WS_G = 452 * MiB;
constexpr size_t WS_END = 484 * MiB;

__device__ __forceinline__ unsigned f2bf(float f) { unsigned u = __builtin_bit_cast(unsigned, f); return (u + 0x7fffu + ((u >> 16) & 1u)) >> 16; }
__device__ __forceinline__ unsigned pk2(float lo, float hi) { return f2bf(lo) | (f2bf(hi) << 16); }
__device__ __forceinline__ float bf2f(bf16_t h) { return __builtin_bit_cast(float, (unsigned)h << 16); }
__device__ __forceinline__ float bflo(unsigned w) { return __builtin_bit_cast(float, w << 16); }
__device__ __forceinline__ float bfhi(unsigned w) { return __builtin_bit_cast(float, w & 0xffff0000u); }
__device__ __forceinline__ float sigmoidf_(float x) { return 1.f / (1.f + __expf(-x)); }
__device__ __forceinline__ float wave_sum(float v) {
#pragma unroll
    for (int o = 1; o < 64; o <<= 1) v += __shfl_xor(v, o);
    return v;
}
#define LDS_WAIT() asm volatile("s_waitcnt lgkmcnt(0)" ::: "memory")

__device__ __forceinline__ int win_src_col(int n) {
    if (n < 512) return n;
    if (n < 1536) return n + 64;
    if (n < 1600) return n - 1024;
    if (n < 3328) return n;
    if (n < 5376) return n + 8;
    if (n < 5384) return n - 2048;
    return -1;
}

namespace pg8 {
constexpr int BM = 256, BK = 64, HALF = 128, HTB = HALF * BK * 2, STAGE_BYTES = 8 * HTB, NXCD = 8, WGM = 8;
__host__ __device__ __forceinline__ int lds_byte(int r, int c) { const int st = (r >> 4) * 2 + (c >> 5), rr = r & 15, cc = c & 31, ob = rr * 64 + cc * 2; return st * 1024 + (ob ^ (((ob >> 9) & 1) << 5)); }
__host__ __device__ __forceinline__ void stage_rc(int b, int& R, int& C) { const int st = b / 1024, sb = b % 1024, swz = sb ^ (((sb >> 9) & 1) << 5); R = (st >> 1) * 16 + swz / 64; C = (st & 1) * 32 + (swz % 64) / 2; }
__host__ __device__ __forceinline__ int perm32(int rho) { const int n = rho >> 4, i = rho & 15; return 8 * (i >> 2) + 4 * n + (i & 3); }
struct Unit { int pm, pn; };
struct Gemm { const bf16_t* A; const bf16_t* Bt; int M, N, K, lda; };
struct StaticOrder {
    int nM, nN, nwg, G, c;
    __device__ void init(int M, int N, int G_, int c_) { nM = M / BM; nN = N / BM; nwg = nM * nN; G = G_; c = c_; }
    __device__ bool next(int i, Unit& u) const {
        const long L = (long)i * G + c; if (L >= nwg) return false;
        int wgid = (int)L; { const int q = nwg / NXCD, r = nwg % NXCD, xcd = wgid % NXCD, off = wgid / NXCD; wgid = (xcd < r ? xcd * (q + 1) : r * (q + 1) + (xcd - r) * q) + off; }
        const int nig = WGM * nN, gid = wgid / nig, fm = gid * WGM, gsz = (nM - fm) < WGM ? (nM - fm) : WGM;
        u.pm = fm + ((wgid % nig) % gsz); u.pn = (wgid % nig) / gsz; return true;
    }
};
__device__ __forceinline__ unsigned cvt_pk_bf16(float lo, float hi) { unsigned r; asm volatile("v_cvt_pk_bf16_f32 %0, %1, %2" : "=v"(r) : "v"(lo), "v"(hi)); return r; }

template <int MODE> struct Epi {
    bf16_t* O; int ldo; float* F; const float* X; const float* gate; const bf16_t* P; int gcol;
    __device__ __forceinline__ void operator()(const f32x4 (&acc)[2][2][4][2], const Unit& u, int wr, int wc, int fr, int fq) const {
        const int row0 = u.pm * BM + wr * 64 + fr, col0 = u.pn * BM + wc * 32 + 8 * fq;
#pragma unroll
        for (int ai = 0; ai < 2; ++ai)
#pragma unroll
            for (int m = 0; m < 4; ++m) {
                const int row = row0 + ai * HALF + m * 16;
#pragma unroll
                for (int bj = 0; bj < 2; ++bj) {
                    const int col = col0 + bj * HALF;
                    f32x4 v0 = acc[ai][bj][m][0], v1 = acc[ai][bj][m][1];
                    if (MODE == 1) {
#pragma unroll
                        for (int j = 0; j < 4; ++j) { float a = fmaxf(v0[j], 0.f), b = fmaxf(v1[j], 0.f); v0[j] = a * a; v1[j] = b * b; }
                    }
                    if (MODE == 2 || MODE == 3) {
                        const u32x4 g = *(const u32x4*)(P + (size_t)row * NPROJ + gcol + col);
                        v0[0] *= sigmoidf_(bflo(g.x)); v0[1] *= sigmoidf_(bfhi(g.x)); v0[2] *= sigmoidf_(bflo(g.y)); v0[3] *= sigmoidf_(bfhi(g.y));
                        v1[0] *= sigmoidf_(bflo(g.z)); v1[1] *= sigmoidf_(bfhi(g.z)); v1[2] *= sigmoidf_(bflo(g.w)); v1[3] *= sigmoidf_(bfhi(g.w));
                    }
                    if (MODE == 3) {
                        const float* fp = F + (size_t)row * DM + col;
                        v0 += *(const f32x4*)fp; v1 += *(const f32x4*)(fp + 4);
                    }
                    if (MODE == 4) {
                        const int b = row / SEQ;
                        const float* gp = gate + (size_t)b * NMOD + col; const float* xp = X + (size_t)row * DM + col;
                        v0 = *(const f32x4*)xp + *(const f32x4*)gp * v0; v1 = *(const f32x4*)(xp + 4) + *(const f32x4*)(gp + 4) * v1;
                    }
                    if (MODE == 0 || MODE == 1 || MODE == 3) {
                        u32x4 w; w.x = cvt_pk_bf16(v0[0], v0[1]); w.y = cvt_pk_bf16(v0[2], v0[3]); w.z = cvt_pk_bf16(v1[0], v1[1]); w.w = cvt_pk_bf16(v1[2], v1[3]);
                        *(u32x4*)(O + (size_t)row * ldo + col) = w;
                    } else {
                        float* fp = F + (size_t)row * DM + col;
                        *(f32x4*)fp = v0; *(f32x4*)(fp + 4) = v1;
                    }
                }
            }
    }
};

template <class EpiT>
__device__ __forceinline__ void gemm_phase(LAS unsigned char* lds, const Gemm g, const StaticOrder& S, const EpiT& E) {
    const int tid = threadIdx.x, wid = __builtin_amdgcn_readfirstlane(tid >> 6), lane = tid & 63, wr = wid >> 2, wc = wid & 3, fr = lane & 15, fq = lane >> 4;
    const int K = g.K, nt = K / BK, lda = g.lda;
    unsigned voffA[2], voffB[2];
#pragma unroll
    for (int i = 0; i < 2; ++i) { int R, C; stage_rc(tid * 16 + i * 8192, R, C); const int Rb = (R & ~31) + perm32(R & 31);
        voffA[i] = (unsigned)(R * lda + C) * 2u; voffB[i] = (unsigned)(Rb * K + C) * 2u; }
    const size_t kstep = (size_t)(BK * 2);
    const size_t hstepA = (size_t)HALF * lda * 2, hstepB = (size_t)HALF * K * 2;
    const size_t tstepA = 2 * hstepA, tstepB = 2 * hstepB;
    const unsigned ldsw = (unsigned)wid * 1024u;
    const int aoff = lds_byte(wr * 64 + fr, fq * 8), boff = lds_byte(wc * 32 + fr, fq * 8);
#define PG8_SA(b, h) (((b) * 2 + (h)) * HTB)
#define PG8_SB(b, h) ((4 + (b) * 2 + (h)) * HTB)
#define PG8_STAGE(bufoff, gbase, voff) do { _Pragma("unroll") for (int _i = 0; _i < 2; ++_i) \
        __builtin_amdgcn_global_load_lds((const unsigned*)((const char*)(gbase) + (voff)[_i]), (LAS unsigned*)(lds + (bufoff) + ldsw + _i * 8192), 16, 0, 0); } while (0)
#define PG8_LDA(dst, b, h) do { _Pragma("unroll") for (int m = 0; m < 4; ++m) _Pragma("unroll") for (int k = 0; k < 2; ++k) dst[m][k] = *(const LAS bf16x8*)(lds + PG8_SA(b, h) + aoff + m * 2048 + k * 1024); } while (0)
#define PG8_LDB(dst, b, h) do { _Pragma("unroll") for (int n = 0; n < 2; ++n) _Pragma("unroll") for (int k = 0; k < 2; ++k) dst[n][k] = *(const LAS bf16x8*)(lds + PG8_SB(b, h) + boff + n * 2048 + k * 1024); } while (0)
#define PG8_MMA(ai, bj, At, Bt) do { __builtin_amdgcn_s_setprio(1); _Pragma("unroll") for (int m = 0; m < 4; ++m) _Pragma("unroll") for (int n = 0; n < 2; ++n) _Pragma("unroll") for (int k = 0; k < 2; ++k) \
        acc[ai][bj][m][n] = __builtin_amdgcn_mfma_f32_16x16x32_bf16(Bt[n][k], At[m][k], acc[ai][bj][m][n], 0, 0, 0); __builtin_amdgcn_s_setprio(0); } while (0)
#define PG8_WAIT_V(n) asm volatile("s_waitcnt vmcnt(" #n ")" ::: "memory")
#define PG8_WAIT_L(n) asm volatile("s_waitcnt lgkmcnt(" #n ")" ::: "memory")
#define PG8_BAR __builtin_amdgcn_s_barrier()
#define PG8_SCHED __builtin_amdgcn_sched_barrier(0)
    Unit cur, nxt; int ui = 0;
    if (!S.next(0, cur)) return;
    f32x4 acc[2][2][4][2];
#pragma unroll
    for (int a = 0; a < 2; ++a)
#pragma unroll
        for (int b = 0; b < 2; ++b)
#pragma unroll
            for (int m = 0; m < 4; ++m)
#pragma unroll
                for (int n = 0; n < 2; ++n) acc[a][b][m][n] = (f32x4){0.f, 0.f, 0.f, 0.f};
    bf16x8 At[4][2], B0[2][2], B1[2][2];
    const char* cA = (const char*)g.A + (size_t)cur.pm * tstepA; const char* cB = (const char*)g.Bt + (size_t)cur.pn * tstepB;
    PG8_STAGE(PG8_SB(0, 0), cB, voffB); PG8_STAGE(PG8_SB(0, 1), cB + hstepB, voffB); PG8_STAGE(PG8_SA(0, 0), cA, voffA); PG8_STAGE(PG8_SA(0, 1), cA + hstepA, voffA);
    if (wr == 1) PG8_BAR;
    PG8_WAIT_V(2); PG8_BAR;
    PG8_STAGE(PG8_SB(1, 0), cB + kstep, voffB); PG8_STAGE(PG8_SA(1, 0), cA + kstep, voffA); PG8_STAGE(PG8_SB(1, 1), cB + hstepB + kstep, voffB);
    PG8_WAIT_V(6); PG8_BAR;
    for (;;) {
        const bool has_next = S.next(ui + 1, nxt);
        const char* nA = has_next ? (const char*)g.A + (size_t)nxt.pm * tstepA : cA; const char* nB = has_next ? (const char*)g.Bt + (size_t)nxt.pn * tstepB : cB;
        for (int t = 0; t < nt; t += 2) {
            const bool last = (t == nt - 2);
            const char* a1 = cA + (size_t)(t + 1) * kstep;
            const char* a2 = last ? nA : cA + (size_t)(t + 2) * kstep; const char* b2 = last ? nB : cB + (size_t)(t + 2) * kstep;
            const char* a3 = a2 + kstep; const char* b3 = b2 + kstep;
            PG8_LDB(B0, 0, 0); PG8_LDB(B1, 0, 1); PG8_SCHED; PG8_LDA(At, 0, 0); PG8_STAGE(PG8_SA(1, 1), a1 + hstepA, voffA);
            PG8_WAIT_V(8); PG8_WAIT_L(0); PG8_BAR; PG8_MMA(0, 0, At, B0); PG8_MMA(0, 1, At, B1); PG8_BAR; PG8_SCHED;
            PG8_LDA(At, 0, 1); PG8_STAGE(PG8_SB(0, 0), b2, voffB); PG8_STAGE(PG8_SB(0, 1), b2 + hstepB, voffB); PG8_STAGE(PG8_SA(0, 0), a2, voffA);
            PG8_WAIT_V(8); PG8_WAIT_L(0); PG8_BAR; PG8_MMA(1, 0, At, B0); PG8_MMA(1, 1, At, B1); PG8_BAR; PG8_SCHED;
            PG8_LDB(B0, 1, 0); PG8_LDB(B1, 1, 1); PG8_SCHED; PG8_LDA(At, 1, 0); PG8_STAGE(PG8_SA(0, 1), a2 + hstepA, voffA);
            PG8_WAIT_V(8); PG8_WAIT_L(0); PG8_BAR; PG8_MMA(0, 0, At, B0); PG8_MMA(0, 1, At, B1); PG8_BAR; PG8_SCHED;
            PG8_LDA(At, 1, 1); PG8_STAGE(PG8_SB(1, 0), b3, voffB); PG8_STAGE(PG8_SB(1, 1), b3 + hstepB, voffB); PG8_STAGE(PG8_SA(1, 0), a3, voffA);
            PG8_WAIT_V(8); PG8_WAIT_L(0); PG8_BAR; PG8_MMA(1, 0, At, B0); PG8_MMA(1, 1, At, B1); PG8_BAR; PG8_SCHED;
        }
        if (wr == 0) PG8_BAR;
        E(acc, cur, wr, wc, fr, fq);
        if (!has_next) break;
#pragma unroll
        for (int a = 0; a < 2; ++a)
#pragma unroll
            for (int b = 0; b < 2; ++b)
#pragma unroll
                for (int m = 0; m < 4; ++m)
#pragma unroll
                    for (int n = 0; n < 2; ++n) acc[a][b][m][n] = (f32x4){0.f, 0.f, 0.f, 0.f};
        cur = nxt; cA = nA; cB = nB; ++ui;
        if (wr == 1) PG8_BAR;
    }
    PG8_WAIT_V(0);
    PG8_BAR;
#undef PG8_SA
#undef PG8_SB
#undef PG8_STAGE
#undef PG8_LDA
#undef PG8_LDB
#undef PG8_MMA
#undef PG8_WAIT_V
#undef PG8_WAIT_L
#undef PG8_BAR
#undef PG8_SCHED
}
}

struct Params { const float* in[25]; float* out; unsigned char* ws; int ph_lo, ph_hi; };
enum { I_X = 0, I_C, I_WADA, I_BADA, I_N1G, I_WIN, I_MU, I_WDU, I_DBASE, I_WIU, I_IBASE, I_WGU, I_KKS, I_KMIX, I_RBON, I_LNW, I_LNB, I_FBIAS, I_WOA, I_WOB, I_WOUT, I_N2G, I_WFF1, I_WFF2, I_FG };

__device__ __forceinline__ void transpose_item(const float* __restrict__ W, int K, int Nsrc, int nblk, bf16_t* WT, LAS float* scr, int item, int lane, bool map) {
    const int kb = item / nblk, nb = item % nblk, k0 = 64 * kb, n0 = 32 * nb;
    const int n = n0 + (lane & 31); const int sc = map ? win_src_col(n) : n;
#pragma unroll 8
    for (int i = 0; i < 32; ++i) { const int kk = 2 * i + (lane >> 5); scr[kk * 33 + (lane & 31)] = (sc >= 0) ? W[(size_t)(k0 + kk) * Nsrc + sc] : 0.f; }
    LDS_WAIT();
    const int c = lane & 7;
#pragma unroll
    for (int j = 0; j < 4; ++j) { const int nn = (lane >> 3) + 8 * j; const LAS float* s = scr + (8 * c) * 33 + nn;
        u32x4 o; o.x = pk2(s[0 * 33], s[1 * 33]); o.y = pk2(s[2 * 33], s[3 * 33]); o.z = pk2(s[4 * 33], s[5 * 33]); o.w = pk2(s[6 * 33], s[7 * 33]);
        *(u32x4*)(WT + (size_t)(n0 + nn) * K + k0 + 8 * c) = o; }
    LDS_WAIT();
}

__device__ __forceinline__ void phase_p0(const Params& p, LAS unsigned char* lds) {
    const int tid = threadIdx.x, lane = tid & 63, wave = tid >> 6;
    const int gw = blockIdx.x * NWAVES + wave, NGW = gridDim.x * NWAVES;
    LAS float* scr = (LAS float*)(lds + wave * 8448);
    LAS float* cact = (LAS float*)(lds + 73728);
    for (int i = tid; i < NB * DM; i += NTHREADS) { const int b = i >> 10, k = i & 1023; const float c = p.in[I_C][i]; cact[k * 8 + b] = c / (1.f + __expf(-c)); }
    __syncthreads();
    unsigned char* ws = p.ws;
    constexpr int I_1 = 16 * 176, I_2 = 8 * 32, I_3 = 8 * 32, I_4 = 16 * 32, I_5 = 16 * 128, I_6 = 64 * 32, I_7 = NMOD / 32;
    constexpr int NITEMS = I_1 + I_2 + I_3 + I_4 + I_5 + I_6 + I_7;
    for (int it = gw; it < NITEMS; it += NGW) {
        int r = it;
        if (r < I_7) {
            const int col = 32 * r + (lane & 31), kh = lane >> 5;
            float acc[8];
#pragma unroll
            for (int b = 0; b < 8; ++b) acc[b] = 0.f;
            const float* wp = p.in[I_WADA] + col;
#pragma unroll 4
            for (int k = kh * 512; k < kh * 512 + 512; ++k) {
                const float wv = wp[(size_t)k * NMOD];
                const f32x4 c0 = *(const LAS f32x4*)(cact + k * 8), c1 = *(const LAS f32x4*)(cact + k * 8 + 4);
                acc[0] += c0[0] * wv; acc[1] += c0[1] * wv; acc[2] += c0[2] * wv; acc[3] += c0[3] * wv;
                acc[4] += c1[0] * wv; acc[5] += c1[1] * wv; acc[6] += c1[2] * wv; acc[7] += c1[3] * wv;
            }
            float* mod = (float*)(ws + WS_MOD);
            const float bias = p.in[I_BADA][col];
#pragma unroll
            for (int b = 0; b < 8; ++b) { const float s = acc[b] + __shfl_xor(acc[b], 32); if (kh == 0) mod[b * NMOD + col] = s + bias; }
            continue;
        }
        r -= I_7;
        if (r < I_1) { transpose_item(p.in[I_WIN], DM, N_IN, NPROJ / 32, (bf16_t*)(ws + WS_WIN), scr, r, lane, true); continue; } r -= I_1;
        if (r < I_2) { transpose_item(p.in[I_WOA], RW, DM, DM / 32, (bf16_t*)(ws + WS_WOA), scr, r, lane, false); continue; } r -= I_2;
        if (r < I_3) { transpose_item(p.in[I_WOB], RW, DM, DM / 32, (bf16_t*)(ws + WS_WOB), scr, r, lane, false); continue; } r -= I_3;
        if (r < I_4) { transpose_item(p.in[I_WOUT], DM, DM, DM / 32, (bf16_t*)(ws + WS_WOUT), scr, r, lane, false); continue; } r -= I_4;
        if (r < I_5) { transpose_item(p.in[I_WFF1], DM, DFF, DFF / 32, (bf16_t*)(ws + WS_WFF1), scr, r, lane, false); continue; } r -= I_5;
        transpose_item(p.in[I_WFF2], DFF, DM, DM / 32, (bf16_t*)(ws + WS_WFF2), scr, r, lane, false);
    }
}

template <int MODE>
__device__ __forceinline__ void phase_norm(const float* X, const float* g, const float* mod, int shoff, int scoff, bf16_t* Hout, float* Fout) {
    const int tid = threadIdx.x, lane = tid & 63, wave = tid >> 6;
    const int gw = blockIdx.x * NWAVES + wave, NGW = gridDim.x * NWAVES;
    for (int m = gw; m < T; m += NGW) {
        const f32x4* xr = (const f32x4*)(X + (size_t)m * DM) + lane;
        f32x4 v[4]; float s = 0.f;
#pragma unroll
        for (int j = 0; j < 4; ++j) { v[j] = xr[64 * j]; s += (v[j].x * v[j].x + v[j].y * v[j].y) + (v[j].z * v[j].z + v[j].w * v[j].w); }
        const float rstd = rsqrtf(wave_sum(s) * (1.f / DM) + NORM_EPS);
        const int b = m / SEQ;
#pragma unroll
        for (int j = 0; j < 4; ++j) {
            const int col = 4 * lane + 256 * j;
            const f32x4 g4 = *(const f32x4*)(g + col);
            f32x4 y = v[j] * rstd * g4;
            if (MODE == 0) {
                const f32x4 sc = *(const f32x4*)(mod + (size_t)b * NMOD + scoff + col), sh = *(const f32x4*)(mod + (size_t)b * NMOD + shoff + col);
                y = y * (sc + 1.f) + sh;
                u32x2 o; o.x = pk2(y.x, y.y); o.y = pk2(y.z, y.w);
                *(u32x2*)(Hout + (size_t)m * DM + col) = o;
            } else {
                *(f32x4*)(Fout + (size_t)m * DM + col) = y;
            }
        }
    }
}

__device__ __forceinline__ float logsigmoidf_(float x) { return fminf(x, 0.f) - log1pf(__expf(-fabsf(x))); }

__device__ __forceinline__ void phase_prep(const Params& p, LAS unsigned char* lds) {
    const int tid = threadIdx.x, lane = tid & 63, wave = tid >> 6;
    LAS float* inb = (LAS float*)lds;
    unsigned char* ws = p.ws;
    const bf16_t* PROJ = (const bf16_t*)(ws + WS_PROJ);
    bf16_t* Rb = (bf16_t*)p.out; bf16_t* Kb = Rb + (size_t)T * RW; bf16_t* Vb = Kb + (size_t)T * RW; bf16_t* Ab = Vb + (size_t)T * RW;
    bf16_t* Bb = (bf16_t*)(ws + WS_B); _Float16* Wb = (_Float16*)(ws + WS_W16); bf16_t* Gb = (bf16_t*)(ws + WS_G);
    const float* mu = p.in[I_MU];
    const int c = tid;
    for (int tile = blockIdx.x; tile < T / 32; tile += gridDim.x) {
        const int t0 = tile * 32;
        {   const int cc = tid & 255, nc = C_WD + cc; const float muv = mu[win_src_col(nc)];
#pragma unroll 4
            for (int i = 0; i < 16; ++i) {
                const int tt = (tid >> 8) + 2 * i, t = t0 + tt;
                const float cur = bf2f(PROJ[(size_t)t * NPROJ + nc]);
                const float prev = (t % SEQ == 0) ? 0.f : bf2f(PROJ[(size_t)(t - 1) * NPROJ + nc]);
                const float pv = cur + muv * (prev - cur);
                const float val = (cc < 64) ? tanhf(pv) : ((cc < 128) ? pv : sigmoidf_(pv));
                inb[cc * 36 + tt] = val;
            }
        }
        __syncthreads();
        float acc[32], av[32];
#pragma unroll
        for (int i = 0; i < 32; ++i) acc[i] = 0.f;
        {   const float* wp = p.in[I_WDU] + c;
#pragma unroll 2
            for (int j = 0; j < 64; ++j) { const float wv = wp[j * RW];
#pragma unroll
                for (int q = 0; q < 8; ++q) { const f32x4 iv = *(const LAS f32x4*)(inb + j * 36 + 4 * q); acc[4 * q] += iv[0] * wv; acc[4 * q + 1] += iv[1] * wv; acc[4 * q + 2] += iv[2] * wv; acc[4 * q + 3] += iv[3] * wv; } }
            const float base = p.in[I_DBASE][c];
#pragma unroll
            for (int i = 0; i < 32; ++i) { const float u = 0.6065306597f * sigmoidf_(base + acc[i]); Wb[(size_t)(t0 + i) * RW + c] = (_Float16)u; }
        }
#pragma unroll
        for (int i = 0; i < 32; ++i) acc[i] = 0.f;
        {   const float* wp = p.in[I_WIU] + c;
#pragma unroll 2
            for (int j = 0; j < 64; ++j) { const float wv = wp[j * RW];
#pragma unroll
                for (int q = 0; q < 8; ++q) { const f32x4 iv = *(const LAS f32x4*)(inb + (64 + j) * 36 + 4 * q); acc[4 * q] += iv[0] * wv; acc[4 * q + 1] += iv[1] * wv; acc[4 * q + 2] += iv[2] * wv; acc[4 * q + 3] += iv[3] * wv; } }
            const float base = p.in[I_IBASE][c];
#pragma unroll
            for (int i = 0; i < 32; ++i) av[i] = sigmoidf_(base + acc[i]);
        }
#pragma unroll
        for (int i = 0; i < 32; ++i) acc[i] = 0.f;
        {   const float* wp = p.in[I_WGU] + c;
#pragma unroll 2
            for (int j = 0; j < 128; ++j) { const float wv = wp[j * RW];
#pragma unroll
                for (int q = 0; q < 8; ++q) { const f32x4 iv = *(const LAS f32x4*)(inb + (128 + j) * 36 + 4 * q); acc[4 * q] += iv[0] * wv; acc[4 * q + 1] += iv[1] * wv; acc[4 * q + 2] += iv[2] * wv; acc[4 * q + 3] += iv[3] * wv; } }
#pragma unroll
            for (int i = 0; i < 32; ++i) Gb[(size_t)(t0 + i) * RW + c] = (bf16_t)f2bf(acc[i]);
        }
        {   const float mur = mu[c], muk = mu[576 + c], muvv = mu[1088 + c], kks = p.in[I_KKS][c], mix = p.in[I_KMIX][c];
#pragma unroll
            for (int i = 0; i < 32; ++i) {
                const int t = t0 + i; const bool first = (t % SEQ == 0);
                const bf16_t* row = PROJ + (size_t)t * NPROJ; const bf16_t* prow = row - NPROJ;
                const float rc = bf2f(row[C_R + c]), kc = bf2f(row[C_K + c]), vc = bf2f(row[C_V + c]);
                const float rp = first ? 0.f : bf2f(prow[C_R + c]), kp = first ? 0.f : bf2f(prow[C_K + c]), vp = first ? 0.f : bf2f(prow[C_V + c]);
                const float r = rc + mur * (rp - rc), k = kc + muk * (kp - kc), v = vc + muvv * (vp - vc);
                float kk = k * kks; const float ss = wave_sum(kk * kk);
                kk = kk / fmaxf(sqrtf(ss), 1e-12f);
                const float a = av[i];
                const size_t o = (size_t)t * RW + c;
                Rb[o] = (bf16_t)f2bf(r); Kb[o] = (bf16_t)f2bf(k * (1.f + (a - 1.f) * mix)); Vb[o] = (bf16_t)f2bf(v);
                Ab[o] = (bf16_t)f2bf(-kk); Bb[o] = (bf16_t)f2bf(kk * a);
            }
        }
        __syncthreads();
    }
    if (wave == 0) {
        float* CUM = (float*)(ws + WS_CUM);
        for (int bh = blockIdx.x; bh < NB * NH; bh += gridDim.x) {
            const int b = bh >> 3, h = bh & 7; const float fb = p.in[I_FBIAS][h];
            const bf16_t* src = PROJ + (size_t)(b * SEQ + lane * 64) * NPROJ + C_FL + h;
            float loc = 0.f;
#pragma unroll 8
            for (int i = 0; i < 64; ++i) loc += logsigmoidf_(bf2f(src[(size_t)i * NPROJ]) + fb);
            float inc = loc;
#pragma unroll
            for (int o = 1; o < 64; o <<= 1) { const float n = __shfl_up(inc, o); if (lane >= o) inc += n; }
            float run = inc - loc;
            float* dst = CUM + (size_t)bh * SEQ + lane * 64;
#pragma unroll 8
            for (int i = 0; i < 64; ++i) { run += logsigmoidf_(bf2f(src[(size_t)i * NPROJ]) + fb); dst[i] = run; }
        }
    }
}

template <int CTRL> __device__ __forceinline__ float dppf(float v) { return __builtin_bit_cast(float, __builtin_amdgcn_update_dpp(0, __builtin_bit_cast(int, v), CTRL, 0xf, 0xf, false)); }
__device__ __forceinline__ float row16_sum(float v) { v += dppf<0x128>(v); v += dppf<0x124>(v); v += dppf<0x122>(v); v += dppf<0x121>(v); return v; }

__device__ __forceinline__ void phase_scan(const Params& p, LAS unsigned char* lds) {
    constexpr int CS = 32, SF = 336, NCH = SEQ / CS;
    const int tid = threadIdx.x, lane = tid & 63, wave = __builtin_amdgcn_readfirstlane(tid >> 6);
    LAS float* buf = (LAS float*)lds;
    LAS float* ybuf = buf + 2 * CS * SF;
    unsigned char* ws = p.ws;
    const bf16_t* Rb = (const bf16_t*)p.out; const bf16_t* Kb = Rb + (size_t)T * RW; const bf16_t* Vb = Kb + (size_t)T * RW; const bf16_t* Ab = Vb + (size_t)T * RW;
    const bf16_t* Bb = (const bf16_t*)(ws + WS_B); const _Float16* Wb = (const _Float16*)(ws + WS_W16);
    unsigned char* Yb = ws + WS_PROJ;
    for (int item = blockIdx.x; item < 256; item += gridDim.x) {
        const int bh = item & 63, rg = item >> 6, b = bh >> 3, h = bh & 7;
        const size_t rowbase = (size_t)b * SEQ; const int colbase = h * 64;
        const int pt = tid - 256, pstep = pt >> 3, c8 = (pt & 7) * 8, i2 = (pt & 7) * 2;
        u32x4 la, lb, lk, lr, lw; unsigned lv;
#define SCAN_LOAD(ch) do { const size_t o = (rowbase + (size_t)(ch) * CS + pstep) * RW + colbase; \
            la = *(const u32x4*)(Ab + o + c8); lb = *(const u32x4*)(Bb + o + c8); lk = *(const u32x4*)(Kb + o + c8); lr = *(const u32x4*)(Rb + o + c8); \
            lw = *(const u32x4*)(Wb + o + c8); lv = *(const unsigned*)(Vb + o + rg * 16 + i2); } while (0)
#define SCAN_ST8(dst, v) do { *(LAS f32x4*)(dst) = (f32x4){bflo((v).x), bfhi((v).x), bflo((v).y), bfhi((v).y)}; *(LAS f32x4*)((dst) + 4) = (f32x4){bflo((v).z), bfhi((v).z), bflo((v).w), bfhi((v).w)}; } while (0)
#define SCAN_WRITE(cb) do { LAS float* d = buf + ((cb) * CS + pstep) * SF; \
            { f32x4 w0, w1; const _Float16* hp = (const _Float16*)&lw; \
              w0[0] = __expf(-(float)hp[0]); w0[1] = __expf(-(float)hp[1]); w0[2] = __expf(-(float)hp[2]); w0[3] = __expf(-(float)hp[3]); \
              w1[0] = __expf(-(float)hp[4]); w1[1] = __expf(-(float)hp[5]); w1[2] = __expf(-(float)hp[6]); w1[3] = __expf(-(float)hp[7]); \
              *(LAS f32x4*)(d + c8) = w0; *(LAS f32x4*)(d + c8 + 4) = w1; } \
            SCAN_ST8(d + 64 + c8, la); SCAN_ST8(d + 128 + c8, lb); SCAN_ST8(d + 192 + c8, lk); SCAN_ST8(d + 256 + c8, lr); \
            *(LAS f32x2*)(d + 320 + i2) = (f32x2){bflo(lv), bfhi(lv)}; } while (0)
#define SCAN_YOUT(ch, cb) do { const f32x2 yv = *(const LAS f32x2*)(ybuf + ((cb) * CS + pstep) * 16 + i2); \
            *(f32x2*)(Yb + (rowbase + (size_t)(ch) * CS + pstep) * (size_t)(NPROJ * 2) + (size_t)(colbase + rg * 16 + i2) * 4) = yv; } while (0)
        if (wave >= 4) { SCAN_LOAD(0); SCAN_WRITE(0); }
        __syncthreads();
        const int rr = lane >> 4, cgp = lane & 15, irow = wave * 4 + rr;
        f32x4 s = {0.f, 0.f, 0.f, 0.f};
        for (int ch = 0; ch < NCH; ++ch) {
            const int cb = ch & 1;
            if (wave >= 4) {
                if (ch + 1 < NCH) SCAN_LOAD(ch + 1);
                if (ch > 0) SCAN_YOUT(ch - 1, cb ^ 1);
                if (ch + 1 < NCH) SCAN_WRITE(cb ^ 1);
            } else {
                const LAS float* bp = buf + cb * CS * SF + 4 * cgp;
                LAS float* yp = ybuf + cb * CS * 16 + irow;
#pragma unroll 4
                for (int st = 0; st < CS; ++st) {
                    const LAS float* q = bp + st * SF;
                    const f32x4 w4 = *(const LAS f32x4*)q, a4 = *(const LAS f32x4*)(q + 64), b4 = *(const LAS f32x4*)(q + 128), k4 = *(const LAS f32x4*)(q + 192), r4 = *(const LAS f32x4*)(q + 256);
                    const float v = bp[st * SF + 320 - 4 * cgp + irow];
                    const float dot = (s[0] * a4[0] + s[1] * a4[1]) + (s[2] * a4[2] + s[3] * a4[3]);
                    const f32x4 pre = s * w4 + k4 * v;
                    const float sa = row16_sum(dot);
                    s = pre + b4 * sa;
                    const float yd = (s[0] * r4[0] + s[1] * r4[1]) + (s[2] * r4[2] + s[3] * r4[3]);
                    const float y = row16_sum(yd);
                    if (cgp == 0) yp[st * 16] = y;
                }
            }
            __syncthreads();
        }
        if (wave >= 4) SCAN_YOUT(NCH - 1, (NCH - 1) & 1);
        __syncthreads();
#undef SCAN_LOAD
#undef SCAN_ST8
#undef SCAN_WRITE
#undef SCAN_YOUT
    }
}

__device__ __forceinline__ int crow(int r, int hi) { return (r & 3) + 8 * (r >> 2) + 4 * hi; }

__device__ __forceinline__ void attn_unit(const Params& p, LAS unsigned char* lds, int b, int h, int qb) {
    constexpr int BUFB = 18688, KOFF = 0, VOFF = 9216, BOFF = 18432;
    constexpr float C2 = 0.125f * LOG2E;
    const int tid = threadIdx.x, lane = tid & 63, wave = __builtin_amdgcn_readfirstlane(tid >> 6), r32 = lane & 31, hi = lane >> 5;
    bf16_t* PROJ = (bf16_t*)(p.ws + WS_PROJ);
    const float* cumg = (const float*)(p.ws + WS_CUM) + (size_t)(b * NH + h) * SEQ;
    const size_t rowbase = (size_t)b * SEQ; const int q0 = qb * 256, qw = q0 + wave * 32;
    LAS float* wsf = (LAS float*)(lds + 2 * BUFB) + wave * 32;
    bf16x8 qr[4];
    {   const bf16_t* Qp = PROJ + (rowbase + qw + r32) * NPROJ + C_FQ + h * 64;
#pragma unroll
        for (int d0 = 0; d0 < 4; ++d0) qr[d0] = *(const bf16x8*)(Qp + d0 * 16 + hi * 8); }
    const bf16_t* Kg = PROJ + rowbase * NPROJ + C_FK + h * 64; const bf16_t* Vg = PROJ + rowbase * NPROJ + C_FV + h * 64;
    const int NT = (q0 + 256) / 64;
    const int lkey = tid >> 3, d8 = (tid & 7) * 8;
    u32x4 kreg, vreg; float kbreg = 0.f;
#define ATT_LOAD(kt) do { const size_t o = (size_t)((kt) * 64 + lkey) * NPROJ + d8; kreg = *(const u32x4*)(Kg + o); vreg = *(const u32x4*)(Vg + o); if (tid < 64) kbreg = -cumg[(kt) * 64 + tid] * LOG2E; } while (0)
#define ATT_WRITE(cb) do { LAS unsigned char* B_ = lds + (cb) * BUFB; *(LAS u32x4*)(B_ + KOFF + lkey * 144 + d8 * 2) = kreg; \
        LAS bf16_t* vt = (LAS bf16_t*)(B_ + VOFF) + d8 * 72 + lkey; \
        vt[0] = (bf16_t)(vreg.x & 0xffffu); vt[72] = (bf16_t)(vreg.x >> 16); vt[144] = (bf16_t)(vreg.y & 0xffffu); vt[216] = (bf16_t)(vreg.y >> 16); \
        vt[288] = (bf16_t)(vreg.z & 0xffffu); vt[360] = (bf16_t)(vreg.z >> 16); vt[432] = (bf16_t)(vreg.w & 0xffffu); vt[504] = (bf16_t)(vreg.w >> 16); \
        if (tid < 64) ((LAS float*)(B_ + BOFF))[tid] = kbreg; } while (0)
    ATT_LOAD(0); ATT_WRITE(0);
    __syncthreads();
    float m = -1e30f, l = 0.f; f32x16 o[2];
#pragma unroll
    for (int r = 0; r < 16; ++r) { o[0][r] = 0.f; o[1][r] = 0.f; }
    for (int kt = 0; kt < NT; ++kt) {
        const int cb = kt & 1;
        if (kt + 1 < NT) ATT_LOAD(kt + 1);
        if (kt * 64 <= qw + 31) {
            const LAS unsigned char* Bf = lds + cb * BUFB;
            f32x16 p0, p1;
#pragma unroll
            for (int r = 0; r < 16; ++r) { p0[r] = 0.f; p1[r] = 0.f; }
#pragma unroll
            for (int d0 = 0; d0 < 4; ++d0) {
                const bf16x8 ka0 = *(const LAS bf16x8*)(Bf + KOFF + r32 * 144 + (d0 * 16 + hi * 8) * 2);
                const bf16x8 ka1 = *(const LAS bf16x8*)(Bf + KOFF + (32 + r32) * 144 + (d0 * 16 + hi * 8) * 2);
                p0 = __builtin_amdgcn_mfma_f32_32x32x16_bf16(ka0, qr[d0], p0, 0, 0, 0);
                p1 = __builtin_amdgcn_mfma_f32_32x32x16_bf16(ka1, qr[d0], p1, 0, 0, 0);
            }
            const LAS float* kbp = (const LAS float*)(Bf + BOFF);
#pragma unroll
            for (int g = 0; g < 4; ++g) {
                const f32x4 kb0 = *(const LAS f32x4*)(kbp + 8 * g + 4 * hi), kb1 = *(const LAS f32x4*)(kbp + 32 + 8 * g + 4 * hi);
#pragma unroll
                for (int j = 0; j < 4; ++j) { p0[4 * g + j] = p0[4 * g + j] * C2 + kb0[j]; p1[4 * g + j] = p1[4 * g + j] * C2 + kb1[j]; }
            }
            if (kt * 64 + 63 > qw) {
                const int qabs = qw + r32;
#pragma unroll
                for (int r = 0; r < 16; ++r) { const int key = kt * 64 + crow(r, hi); if (key > qabs) p0[r] = -INFINITY; if (key + 32 > qabs) p1[r] = -INFINITY; }
            }
            float rm = fmaxf(p0[0], p1[0]);
#pragma unroll
            for (int r = 1; r < 16; ++r) rm = fmaxf(rm, fmaxf(p0[r], p1[r]));
            rm = fmaxf(rm, __shfl_xor(rm, 32));
            const float mnew = fmaxf(m, rm), alpha = exp2f(m - mnew); m = mnew;
            float rs = 0.f;
#pragma unroll
            for (int r = 0; r < 16; ++r) { p0[r] = exp2f(p0[r] - mnew); p1[r] = exp2f(p1[r] - mnew); rs += p0[r] + p1[r]; }
            l = l * alpha + rs;
            if (hi == 0) wsf[r32] = alpha;
            LDS_WAIT();
#pragma unroll
            for (int g = 0; g < 4; ++g) { const f32x4 al = *(const LAS f32x4*)(wsf + 8 * g + 4 * hi);
#pragma unroll
                for (int j = 0; j < 4; ++j) { o[0][4 * g + j] *= al[j]; o[1][4 * g + j] *= al[j]; } }
            u32x4 pw[4];
            pw[0] = (u32x4){pk2(p0[0], p0[1]), pk2(p0[2], p0[3]), pk2(p0[4], p0[5]), pk2(p0[6], p0[7])};
            pw[1] = (u32x4){pk2(p0[8], p0[9]), pk2(p0[10], p0[11]), pk2(p0[12], p0[13]), pk2(p0[14], p0[15])};
            pw[2] = (u32x4){pk2(p1[0], p1[1]), pk2(p1[2], p1[3]), pk2(p1[4], p1[5]), pk2(p1[6], p1[7])};
            pw[3] = (u32x4){pk2(p1[8], p1[9]), pk2(p1[10], p1[11]), pk2(p1[12], p1[13]), pk2(p1[14], p1[15])};
#pragma unroll
            for (int d0 = 0; d0 < 2; ++d0)
#pragma unroll
                for (int sl = 0; sl < 4; ++sl) {
                    const int base = 32 * (sl >> 1) + 16 * (sl & 1) + 4 * hi;
                    const LAS unsigned char* vp = Bf + VOFF + (d0 * 32 + r32) * 144 + base * 2;
                    const u32x2 lo = *(const LAS u32x2*)vp, hh = *(const LAS u32x2*)(vp + 16);
                    const u32x4 vv = {lo.x, lo.y, hh.x, hh.y};
                    o[d0] = __builtin_amdgcn_mfma_f32_32x32x16_bf16(__builtin_bit_cast(bf16x8, pw[sl]), __builtin_bit_cast(bf16x8, vv), o[d0], 0, 0, 0);
                }
        }
        if (kt + 1 < NT) ATT_WRITE(cb ^ 1);
        __syncthreads();
    }
#undef ATT_LOAD
#undef ATT_WRITE
    l += __shfl_xor(l, 32);
    if (hi == 0) wsf[r32] = 1.f / l;
    LDS_WAIT();
    bf16_t* Op = PROJ + (rowbase + qw) * NPROJ + C_FQ + h * 64 + r32;
#pragma unroll
    for (int g = 0; g < 4; ++g) { const f32x4 rl = *(const LAS f32x4*)(wsf + 8 * g + 4 * hi);
#pragma unroll
        for (int j = 0; j < 4; ++j) { const int r = 4 * g + j; bf16_t* orow = Op + (size_t)crow(r, hi) * NPROJ;
            orow[0] = (bf16_t)f2bf(o[0][r] * rl[j]); orow[32] = (bf16_t)f2bf(o[1][r] * rl[j]); } }
    LDS_WAIT();
}

__device__ __forceinline__ void phase_attn(const Params& p, LAS unsigned char* lds) {
    for (int vb = blockIdx.x; vb < 256; vb += gridDim.x) {
        const int bh = vb >> 2, sub = vb & 3, b = bh >> 3, h = bh & 7;
        for (int ui = 0; ui < 4; ++ui) {
            const int qb = (ui == 0) ? sub : (ui == 1) ? 7 - sub : (ui == 2) ? 8 + sub : 15 - sub;
            attn_unit(p, lds, b, h, qb);
        }
    }
}

__device__ __forceinline__ void phase_fin(const Params& p) {
    const int tid = threadIdx.x, lane = tid & 63, wave = tid >> 6;
    const int gw = blockIdx.x * NWAVES + wave, NGW = gridDim.x * NWAVES;
    unsigned char* ws = p.ws;
    const bf16_t* Rb = (const bf16_t*)p.out; const bf16_t* Kb = Rb + (size_t)T * RW; const bf16_t* Vb = Kb + (size_t)T * RW;
    const bf16_t* Gb = (const bf16_t*)(ws + WS_G);
    unsigned char* PROJb = ws + WS_PROJ;
    for (int it = gw; it < T * NH; it += NGW) {
        const int t = it >> 3, h = it & 7, c = h * 64 + lane;
        const float y = *(const float*)(PROJb + (size_t)t * (NPROJ * 2) + (size_t)c * 4);
        const float mean = wave_sum(y) * (1.f / 64.f); const float d = y - mean;
        const float var = wave_sum(d * d) * (1.f / 64.f);
        const float yn = d * rsqrtf(var + GN_EPS) * p.in[I_LNW][c] + p.in[I_LNB][c];
        const size_t o = (size_t)t * RW + c;
        const float r = bf2f(Rb[o]), k = bf2f(Kb[o]), v = bf2f(Vb[o]), g = bf2f(Gb[o]);
        const float bon = wave_sum(r * k * p.in[I_RBON][c]) * v;
        ((bf16_t*)PROJb)[(size_t)t * NPROJ + C_V + c] = (bf16_t)f2bf((yn + bon) * g);
    }
}

__global__ void __launch_bounds__(NTHREADS, 2) fwd_kernel(Params p) {
    extern __shared__ __attribute__((aligned(16))) unsigned char lds_raw[];
    LAS unsigned char* lds = (LAS unsigned char*)lds_raw;
    cg::grid_group grid = cg::this_grid();
    const int lo = p.ph_lo, hi = p.ph_hi;
    unsigned char* ws = p.ws;
    float* mod = (float*)(ws + WS_MOD);
    bf16_t* PROJ = (bf16_t*)(ws + WS_PROJ);
    const int G = gridDim.x, bx = blockIdx.x;
#define IN(k) (lo <= (k) && (k) < hi)
#define SEAM(k) do { if (IN(k) && IN((k) + 1)) grid.sync(); } while (0)
    if (IN(0)) { phase_p0(p, lds); } SEAM(0);
    if (IN(1)) { phase_norm<0>(p.in[I_X], p.in[I_N1G], mod, 0, 1024, (bf16_t*)(ws + WS_H), nullptr); } SEAM(1);
    if (IN(2)) {
        pg8::Gemm g{(const bf16_t*)(ws + WS_H), (const bf16_t*)(ws + WS_WIN), T, NPROJ, DM, DM}; pg8::StaticOrder S; S.init(T, NPROJ, G, bx);
        pg8::Epi<0> E{PROJ, NPROJ, nullptr, nullptr, nullptr, nullptr, 0};
        pg8::gemm_phase(lds, g, S, E);
    } SEAM(2);
    if (IN(3)) { phase_prep(p, lds); } SEAM(3);
    if (IN(4)) { phase_scan(p, lds); }
    if (IN(5)) { __syncthreads(); phase_attn(p, lds); } SEAM(5);
    if (IN(6)) { phase_fin(p); } SEAM(6);
    if (IN(7)) {
        {   pg8::Gemm g{PROJ + C_V, (const bf16_t*)(ws + WS_WOA), T, DM, RW, NPROJ}; pg8::StaticOrder S; S.init(T, DM, G, bx);
            pg8::Epi<2> E{nullptr, 0, p.out, nullptr, nullptr, PROJ, C_GA};
            pg8::gemm_phase(lds, g, S, E); }
        {   pg8::Gemm g{PROJ + C_FQ, (const bf16_t*)(ws + WS_WOB), T, DM, RW, NPROJ}; pg8::StaticOrder S; S.init(T, DM, G, bx);
            pg8::Epi<3> E{(bf16_t*)(ws + WS_H), DM, p.out, nullptr, nullptr, PROJ, C_GB};
            pg8::gemm_phase(lds, g, S, E); }
    } SEAM(7);
    if (IN(8)) {
        pg8::Gemm g{(const bf16_t*)(ws + WS_H), (const bf16_t*)(ws + WS_WOUT), T, DM, DM, DM}; pg8::StaticOrder S; S.init(T, DM, G, bx);
        pg8::Epi<4> E{nullptr, 0, p.out, p.in[I_X], mod + 2048, nullptr, 0};
        pg8::gemm_phase(lds, g, S, E);
    } SEAM(8);
    if (IN(9)) { phase_norm<0>(p.out, p.in[I_N2G], mod, 3072, 4096, (bf16_t*)(ws + WS_H), nullptr); } SEAM(9);
    if (IN(10)) {
        pg8::Gemm g{(const bf16_t*)(ws + WS_H), (const bf16_t*)(ws + WS_WFF1), T, DFF, DM, DM}; pg8::StaticOrder S; S.init(T, DFF, G, bx);
        pg8::Epi<1> E{PROJ, DFF, nullptr, nullptr, nullptr, nullptr, 0};
        pg8::gemm_phase(lds, g, S, E);
    } SEAM(10);
    if (IN(11)) {
        pg8::Gemm g{PROJ, (const bf16_t*)(ws + WS_WFF2), T, DM, DFF, DFF}; pg8::StaticOrder S; S.init(T, DM, G, bx);
        pg8::Epi<4> E{nullptr, 0, p.out, p.out, mod + 5120, nullptr, 0};
        pg8::gemm_phase(lds, g, S, E);
    } SEAM(11);
    if (IN(12)) { phase_norm<1>(p.out, p.in[I_FG], nullptr, 0, 0, nullptr, p.out); }
#undef IN
#undef SEAM
}

extern "C" void kernel_launch(void* const* d_in, const int* in_sizes, int n_in, void* d_out, int out_size, void* d_ws, size_t ws_size, hipStream_t stream) {
    static int grid = 0;
    if (grid == 0) {
        if (n_in != 25 || out_size != T * DM || ws_size < WS_END) { fprintf(stderr, "kernel_launch: unexpected shapes (n_in %d out %d ws %zu)\n", n_in, out_size, ws_size); grid = -1; return; }
        int dev = 0, cus = 0, per_cu = 0;
        hipGetDevice(&dev);
        hipDeviceGetAttribute(&cus, hipDeviceAttributeMultiprocessorCount, dev);
        if (hipFuncSetAttribute((const void*)fwd_kernel, hipFuncAttributeMaxDynamicSharedMemorySize, LDS_BYTES) != hipSuccess) { fprintf(stderr, "kernel_launch: hipFuncSetAttribute failed\n"); grid = -1; return; }
        if (hipOccupancyMaxActiveBlocksPerMultiprocessor(&per_cu, (const void*)fwd_kernel, NTHREADS, LDS_BYTES) != hipSuccess || per_cu < 1) { fprintf(stderr, "kernel_launch: occupancy query failed (%d)\n", per_cu); (void)hipGetLastError(); per_cu = 1; }
        grid = cus * (per_cu > 1 ? 1 : per_cu);
        fprintf(stderr, "kernel_launch: grid %d (cus %d, per_cu %d)\n", grid, cus, per_cu);
    }
    if (grid < 0) return;
    Params p{};
    for (int i = 0; i < 25; ++i) p.in[i] = (const float*)d_in[i];
    p.out = (float*)d_out; p.ws = (unsigned char*)d_ws;
#if N_LAUNCH_MODE == 0
    p.ph_lo = 0; p.ph_hi = NPHASE;
    void* args[] = {&p};
    hipError_t e = hipLaunchCooperativeKernel((const void*)fwd_kernel, dim3(grid), dim3(NTHREADS), args, LDS_BYTES, stream);
    if (e != hipSuccess) fprintf(stderr, "cooperative launch failed: %s (grid %d)\n", hipGetErrorString(e), grid);
#else
    for (int ph = 0; ph < NPHASE; ++ph) {
        if (ph == 5) continue;
        p.ph_lo = ph; p.ph_hi = (ph == 4) ? 6 : ph + 1;
        hipLaunchKernelGGL(fwd_kernel, dim3(grid), dim3(NTHREADS), LDS_BYTES, stream, p);
    }
#endif
}
```

```cpp
#include <hip/hip_runtime.h>
#include <hip/hip_cooperative_groups.h>
#include <cstdio>
#include <cstdint>
namespace cg = cooperative_groups;

#ifndef N_LAUNCH_MODE
#define N_LAUNCH_MODE 0
#endif

#ifndef PROBE_SUB
#define PROBE_SUB 0
#endif
#define PSUB_T0(k) unsigned long long _st0 = 0; if (PROBE_SUB == (k)) _st0 = __builtin_amdgcn_s_memrealtime();
#define PSUB_T1(k) if (PROBE_SUB == (k)) _sacc += __builtin_amdgcn_s_memrealtime() - _st0;
#define PSUB_SPIN() if (PROBE_SUB != 0) { __syncthreads(); const unsigned long long _end = __builtin_amdgcn_s_memrealtime() + 3 * _sacc; while (__builtin_amdgcn_s_memrealtime() < _end) __builtin_amdgcn_s_sleep(16); }
#define LAS __attribute__((address_space(3)))
typedef unsigned short bf16_t;
typedef short bf16x8 __attribute__((ext_vector_type(8)));
typedef float f32x4 __attribute__((ext_vector_type(4)));
typedef float f32x2 __attribute__((ext_vector_type(2)));
typedef float f32x16 __attribute__((ext_vector_type(16)));
typedef unsigned u32x4 __attribute__((ext_vector_type(4)));
typedef unsigned u32x2 __attribute__((ext_vector_type(2)));

constexpr int NB = 8, SEQ = 4096, DM = 1024, T = NB * SEQ, NH = 8, HD = 64, RW = 512, DFF = 4096, NMOD = 6144;
constexpr int N_IN = 5384, NPROJ = 5632;
constexpr int C_R = 0, C_K = 512, C_V = 1024, C_WD = 1536, C_AD = 1600, C_GD = 1664, C_FQ = 1792, C_FK = 2304, C_FV = 2816, C_GA = 3328, C_GB = 4352, C_FL = 5376;
constexpr float NORM_EPS = 1e-6f, GN_EPS = 64e-5f, LOG2E = 1.4426950408889634f;
constexpr int NWAVES = 8, NTHREADS = 512, LDS_BYTES = 135168;
constexpr int NPHASE = 16;

constexpr size_t MiB = 1u << 20;
constexpr size_t WS_WIN = 0, WS_WOA = 11 * MiB, WS_WOB = 12 * MiB, WS_WOUT = 13 * MiB, WS_WFF1 = 15 * MiB, WS_WFF2 = 23 * MiB;
constexpr size_t WS_MOD = 31 * MiB, WS_CUM = 32 * MiB, WS_WLR = 33 * MiB;
constexpr size_t WS_CTL = 34 * MiB, CTL_BYTES = 16384;
constexpr size_t WS_LR = 484 * MiB;
constexpr size_t WS_AI = 36 * MiB;
constexpr size_t WS_H = 36 * MiB;
constexpr size_t WS_B = 36 * MiB, WS_W16 = 68 * MiB;
constexpr size_t WS_PROJ = 100 * MiB;
constexpr size_t WS_X1B = 356 * MiB;
constexpr size_t WS_G = 452 * MiB;
constexpr size_t WS_BON = 500 * MiB, WS_DC = 501 * MiB;
constexpr size_t WS_END = 502 * MiB;

__device__ __forceinline__ unsigned f2bf(float f) { unsigned u = __builtin_bit_cast(unsigned, f); return (u + 0x7fffu + ((u >> 16) & 1u)) >> 16; }
__device__ __forceinline__ unsigned pk2(float lo, float hi) { typedef __bf16 bf2_t __attribute__((ext_vector_type(2))); const f32x2 v = {lo, hi}; return __builtin_bit_cast(unsigned, __builtin_convertvector(v, bf2_t)); }
__device__ __forceinline__ float bf2f(bf16_t h) { return __builtin_bit_cast(float, (unsigned)h << 16); }
__device__ __forceinline__ float bflo(unsigned w) { return __builtin_bit_cast(float, w << 16); }
__device__ __forceinline__ float bfhi(unsigned w) { return __builtin_bit_cast(float, w & 0xffff0000u); }
__device__ __forceinline__ float sigmoidf_(float x) { return 1.f / (1.f + __expf(-x)); }
__device__ __forceinline__ float wave_sum(float v) {
#pragma unroll
    for (int o = 1; o < 64; o <<= 1) v += __shfl_xor(v, o);
    return v;
}
#define LDS_WAIT() asm volatile("s_waitcnt lgkmcnt(0)" ::: "memory")
#define LBAR() asm volatile("s_waitcnt lgkmcnt(0)\n\ts_barrier" ::: "memory")

__device__ __forceinline__ int win_src_col(int n) {
    if (n < 512) return n;
    if (n < 1536) return n + 64;
    if (n < 1600) return n - 1024;
    if (n < 3328) return n;
    if (n < 5376) return n + 8;
    if (n < 5384) return n - 2048;
    return -1;
}

namespace pg8 {
constexpr int BM = 256, BK = 64, HALF = 128, HTB = HALF * BK * 2, STAGE_BYTES = 8 * HTB, NXCD = 8, WGM = 8;
__host__ __device__ __forceinline__ int lds_byte(int r, int c) { const int st = (r >> 4) * 2 + (c >> 5), rr = r & 15, cc = c & 31, ob = rr * 64 + cc * 2; return st * 1024 + (ob ^ (((ob >> 9) & 1) << 5)); }
__host__ __device__ __forceinline__ void stage_rc(int b, int& R, int& C) { const int st = b / 1024, sb = b % 1024, swz = sb ^ (((sb >> 9) & 1) << 5); R = (st >> 1) * 16 + swz / 64; C = (st & 1) * 32 + (swz % 64) / 2; }
__host__ __device__ __forceinline__ int perm32(int rho) { const int n = rho >> 4, i = rho & 15; return 8 * (i >> 2) + 4 * n + (i & 3); }
struct Unit { int pm, pn; };
struct Gemm { const bf16_t* A; const bf16_t* Bt; int M, N, K, lda; };
struct StaticOrder {
    int nM, nN, nwg, G, c;
    __device__ void init(int M, int N, int G_, int c_) { nM = M / BM; nN = N / BM; nwg = nM * nN; G = G_; c = c_; }
    __device__ bool next(int i, Unit& u) const {
        const long L = (long)i * G + c; if (L >= nwg) return false;
        int wgid = (int)L; { const int q = nwg / NXCD, r = nwg % NXCD, xcd = wgid % NXCD, off = wgid / NXCD; wgid = (xcd < r ? xcd * (q + 1) : r * (q + 1) + (xcd - r) * q) + off; }
        const int nig = WGM * nN, gid = wgid / nig, fm = gid * WGM, gsz = (nM - fm) < WGM ? (nM - fm) : WGM;
        u.pm = fm + ((wgid % nig) % gsz); u.pn = (wgid % nig) / gsz; return true;
    }
};
__device__ __forceinline__ unsigned cvt_pk_bf16(float lo, float hi) { unsigned r; asm volatile("v_cvt_pk_bf16_f32 %0, %1, %2" : "=v"(r) : "v"(lo), "v"(hi)); return r; }

template <int MODE> struct Epi {
    bf16_t* O; int ldo; float* F; const float* X; const float* gate; const bf16_t* P; int gcol; bf16_t* O2; bf16_t* O3;
    __device__ __forceinline__ void operator()(const f32x4 (&acc)[2][2][4][2], const Unit& u, int wr, int wc, int fr, int fq) const {
        const int row0 = u.pm * BM + wr * 64 + fr, col0 = u.pn * BM + wc * 32 + 8 * fq;
#pragma unroll
        for (int ai = 0; ai < 2; ++ai)
#pragma unroll
            for (int m = 0; m < 4; ++m) {
                const int row = row0 + ai * HALF + m * 16;
#pragma unroll
                for (int bj = 0; bj < 2; ++bj) {
                    const int col = col0 + bj * HALF;
                    f32x4 v0 = acc[ai][bj][m][0], v1 = acc[ai][bj][m][1];
                    if (MODE == 1) {
#pragma unroll
                        for (int j = 0; j < 4; ++j) { float a = fmaxf(v0[j], 0.f), b = fmaxf(v1[j], 0.f); v0[j] = a * a; v1[j] = b * b; }
                    }
                    if (MODE == 2 || MODE == 3) {
                        const u32x4 g = *(const u32x4*)(P + (size_t)row * NPROJ + gcol + col);
                        v0[0] *= sigmoidf_(bflo(g.x)); v0[1] *= sigmoidf_(bfhi(g.x)); v0[2] *= sigmoidf_(bflo(g.y)); v0[3] *= sigmoidf_(bfhi(g.y));
                        v1[0] *= sigmoidf_(bflo(g.z)); v1[1] *= sigmoidf_(bfhi(g.z)); v1[2] *= sigmoidf_(bflo(g.w)); v1[3] *= sigmoidf_(bfhi(g.w));
                    }
                    if (MODE == 3) {
                        const u32x4 pp = *(const u32x4*)(O + (size_t)row * ldo + col);
                        v0[0] += bflo(pp.x); v0[1] += bfhi(pp.x); v0[2] += bflo(pp.y); v0[3] += bfhi(pp.y);
                        v1[0] += bflo(pp.z); v1[1] += bfhi(pp.z); v1[2] += bflo(pp.w); v1[3] += bfhi(pp.w);
                    }
                    if (MODE == 4 || MODE == 7) {
                        const int b = row / SEQ;
                        const float* gp = gate + (size_t)b * NMOD + col; const float* xp = X + (size_t)row * DM + col;
                        v0 = *(const f32x4*)xp + *(const f32x4*)gp * v0; v1 = *(const f32x4*)(xp + 4) + *(const f32x4*)(gp + 4) * v1;
                    }
                    if (MODE == 8) {
                        const int b = row / SEQ;
                        const float* gp = gate + (size_t)b * NMOD + col; const u32x4 xb = *(const u32x4*)(P + (size_t)row * DM + col);
                        const f32x4 x0 = {bflo(xb.x), bfhi(xb.x), bflo(xb.y), bfhi(xb.y)}, x1 = {bflo(xb.z), bfhi(xb.z), bflo(xb.w), bfhi(xb.w)};
                        v0 = x0 + *(const f32x4*)gp * v0; v1 = x1 + *(const f32x4*)(gp + 4) * v1;
                    }
                    if (MODE == 5) {
                        const int seg = u.pn >> 1, c = col - seg * RW;
                        if (seg == 0) {
                            const f32x4 b0 = *(const f32x4*)(X + c), b1 = *(const f32x4*)(X + c + 4);
                            typedef _Float16 h8 __attribute__((ext_vector_type(8))); h8 hv;
#pragma unroll
                            for (int j = 0; j < 4; ++j) { hv[j] = (_Float16)(0.6065306597f * sigmoidf_(b0[j] + v0[j])); hv[4 + j] = (_Float16)(0.6065306597f * sigmoidf_(b1[j] + v1[j])); }
                            *(h8*)((_Float16*)O2 + (size_t)row * RW + c) = hv;
                        } else if (seg == 1) {
                            const f32x4 b0 = *(const f32x4*)(gate + c), b1 = *(const f32x4*)(gate + c + 4);
#pragma unroll
                            for (int j = 0; j < 4; ++j) { v0[j] = sigmoidf_(b0[j] + v0[j]); v1[j] = sigmoidf_(b1[j] + v1[j]); }
                            u32x4 w; w.x = cvt_pk_bf16(v0[0], v0[1]); w.y = cvt_pk_bf16(v0[2], v0[3]); w.z = cvt_pk_bf16(v1[0], v1[1]); w.w = cvt_pk_bf16(v1[2], v1[3]);
                            *(u32x4*)(O + (size_t)row * RW + c) = w;
                        } else {
                            u32x4 w; w.x = cvt_pk_bf16(v0[0], v0[1]); w.y = cvt_pk_bf16(v0[2], v0[3]); w.z = cvt_pk_bf16(v1[0], v1[1]); w.w = cvt_pk_bf16(v1[2], v1[3]);
                            *(u32x4*)(O3 + (size_t)row * RW + c) = w;
                        }
                    } else if (MODE == 0 || MODE == 1 || MODE == 2 || MODE == 3 || MODE == 7 || MODE == 8) {
                        u32x4 w; w.x = cvt_pk_bf16(v0[0], v0[1]); w.y = cvt_pk_bf16(v0[2], v0[3]); w.z = cvt_pk_bf16(v1[0], v1[1]); w.w = cvt_pk_bf16(v1[2], v1[3]);
                        *(u32x4*)(O + (size_t)row * ldo + col) = w;
                    } else {
                        float* fp = F + (size_t)row * DM + col;
                        *(f32x4*)fp = v0; *(f32x4*)(fp + 4) = v1;
                    }
                }
            }
    }
};

template <class EpiT>
__device__ __forceinline__ void gemm_phase(LAS unsigned char* lds, const Gemm g, const StaticOrder& S, const EpiT& E) {
    const int tid = threadIdx.x, wid = __builtin_amdgcn_readfirstlane(tid >> 6), lane = tid & 63, wr = wid >> 2, wc = wid & 3, fr = lane & 15, fq = lane >> 4;
    const int K = g.K, nt = K / BK, lda = g.lda;
    unsigned voffA[2], voffB[2];
#pragma unroll
    for (int i = 0; i < 2; ++i) { int R, C; stage_rc(tid * 16 + i * 8192, R, C); const int Rb = (R & ~31) + perm32(R & 31);
        voffA[i] = (unsigned)(R * lda + C) * 2u; voffB[i] = (unsigned)(Rb * K + C) * 2u; }
    const size_t kstep = (size_t)(BK * 2);
    const size_t hstepA = (size_t)HALF * lda * 2, hstepB = (size_t)HALF * K * 2;
    const size_t tstepA = 2 * hstepA, tstepB = 2 * hstepB;
    const unsigned ldsw = (unsigned)wid * 1024u;
    const int aoff = lds_byte(wr * 64 + fr, fq * 8), boff = lds_byte(wc * 32 + fr, fq * 8);
#define PG8_SA(b, h) (((b) * 2 + (h)) * HTB)
#define PG8_SB(b, h) ((4 + (b) * 2 + (h)) * HTB)
#define PG8_STAGE(bufoff, gbase, voff) do { _Pragma("unroll") for (int _i = 0; _i < 2; ++_i) \
        __builtin_amdgcn_global_load_lds((const unsigned*)((const char*)(gbase) + (voff)[_i]), (LAS unsigned*)(lds + (bufoff) + ldsw + _i * 8192), 16, 0, 0); } while (0)
#define PG8_LDA(dst, b, h) do { _Pragma("unroll") for (int m = 0; m < 4; ++m) _Pragma("unroll") for (int k = 0; k < 2; ++k) dst[m][k] = *(const LAS bf16x8*)(lds + PG8_SA(b, h) + aoff + m * 2048 + k * 1024); } while (0)
#define PG8_LDB(dst, b, h) do { _Pragma("unroll") for (int n = 0; n < 2; ++n) _Pragma("unroll") for (int k = 0; k < 2; ++k) dst[n][k] = *(const LAS bf16x8*)(lds + PG8_SB(b, h) + boff + n * 2048 + k * 1024); } while (0)
#define PG8_MMA(ai, bj, At, Bt) do { __builtin_amdgcn_s_setprio(1); _Pragma("unroll") for (int m = 0; m < 4; ++m) _Pragma("unroll") for (int n = 0; n < 2; ++n) _Pragma("unroll") for (int k = 0; k < 2; ++k) \
        acc[ai][bj][m][n] = __builtin_amdgcn_mfma_f32_16x16x32_bf16(Bt[n][k], At[m][k], acc[ai][bj][m][n], 0, 0, 0); __builtin_amdgcn_s_setprio(0); } while (0)
#define PG8_WAIT_V(n) asm volatile("s_waitcnt vmcnt(" #n ")" ::: "memory")
#define PG8_WAIT_L(n) asm volatile("s_waitcnt lgkmcnt(" #n ")" ::: "memory")
#define PG8_BAR __builtin_amdgcn_s_barrier()
#define PG8_SCHED __builtin_amdgcn_sched_barrier(0)
    Unit cur, nxt; int ui = 0;
    if (!S.next(0, cur)) return;
    f32x4 acc[2][2][4][2];
#pragma unroll
    for (int a = 0; a < 2; ++a)
#pragma unroll
        for (int b = 0; b < 2; ++b)
#pragma unroll
            for (int m = 0; m < 4; ++m)
#pragma unroll
                for (int n = 0; n < 2; ++n) acc[a][b][m][n] = (f32x4){0.f, 0.f, 0.f, 0.f};
    bf16x8 At[4][2], B0[2][2], B1[2][2];
    const char* cA = (const char*)g.A + (size_t)cur.pm * tstepA; const char* cB = (const char*)g.Bt + (size_t)cur.pn * tstepB;
    PG8_STAGE(PG8_SB(0, 0), cB, voffB); PG8_STAGE(PG8_SB(0, 1), cB + hstepB, voffB); PG8_STAGE(PG8_SA(0, 0), cA, voffA); PG8_STAGE(PG8_SA(0, 1), cA + hstepA, voffA);
    if (wr == 1) PG8_BAR;
    PG8_WAIT_V(2); PG8_BAR;
    PG8_STAGE(PG8_SB(1, 0), cB + kstep, voffB); PG8_STAGE(PG8_SA(1, 0), cA + kstep, voffA); PG8_STAGE(PG8_SB(1, 1), cB + hstepB + kstep, voffB);
    PG8_WAIT_V(6); PG8_BAR;
    for (;;) {
        const bool has_next = S.next(ui + 1, nxt);
        const char* nA = has_next ? (const char*)g.A + (size_t)nxt.pm * tstepA : cA; const char* nB = has_next ? (const char*)g.Bt + (size_t)nxt.pn * tstepB : cB;
        for (int t = 0; t < nt; t += 2) {
            const bool last = (t == nt - 2);
            const char* a1 = cA + (size_t)(t + 1) * kstep;
            const char* a2 = last ? nA : cA + (size_t)(t + 2) * kstep; const char* b2 = last ? nB : cB + (size_t)(t + 2) * kstep;
            const char* a3 = a2 + kstep; const char* b3 = b2 + kstep;
            PG8_LDB(B0, 0, 0); PG8_LDB(B1, 0, 1); PG8_SCHED; PG8_LDA(At, 0, 0); PG8_STAGE(PG8_SA(1, 1), a1 + hstepA, voffA);
            PG8_WAIT_V(8); PG8_WAIT_L(0); PG8_BAR; PG8_MMA(0, 0, At, B0); PG8_MMA(0, 1, At, B1); PG8_BAR; PG8_SCHED;
            PG8_LDA(At, 0, 1); PG8_STAGE(PG8_SB(0, 0), b2, voffB); PG8_STAGE(PG8_SB(0, 1), b2 + hstepB, voffB); PG8_STAGE(PG8_SA(0, 0), a2, voffA);
            PG8_WAIT_V(8); PG8_WAIT_L(0); PG8_BAR; PG8_MMA(1, 0, At, B0); PG8_MMA(1, 1, At, B1); PG8_BAR; PG8_SCHED;
            PG8_LDB(B0, 1, 0); PG8_LDB(B1, 1, 1); PG8_SCHED; PG8_LDA(At, 1, 0); PG8_STAGE(PG8_SA(0, 1), a2 + hstepA, voffA);
            PG8_WAIT_V(8); PG8_WAIT_L(0); PG8_BAR; PG8_MMA(0, 0, At, B0); PG8_MMA(0, 1, At, B1); PG8_BAR; PG8_SCHED;
            PG8_LDA(At, 1, 1); PG8_STAGE(PG8_SB(1, 0), b3, voffB); PG8_STAGE(PG8_SB(1, 1), b3 + hstepB, voffB); PG8_STAGE(PG8_SA(1, 0), a3, voffA);
            PG8_WAIT_V(8); PG8_WAIT_L(0); PG8_BAR; PG8_MMA(1, 0, At, B0); PG8_MMA(1, 1, At, B1); PG8_BAR; PG8_SCHED;
        }
        if (wr == 0) PG8_BAR;
        E(acc, cur, wr, wc, fr, fq);
        if (!has_next) break;
#pragma unroll
        for (int a = 0; a < 2; ++a)
#pragma unroll
            for (int b = 0; b < 2; ++b)
#pragma unroll
                for (int m = 0; m < 4; ++m)
#pragma unroll
                    for (int n = 0; n < 2; ++n) acc[a][b][m][n] = (f32x4){0.f, 0.f, 0.f, 0.f};
        cur = nxt; cA = nA; cB = nB; ++ui;
        if (wr == 1) PG8_BAR;
    }
    PG8_WAIT_V(0);
    PG8_BAR;
#undef PG8_SA
#undef PG8_SB
#undef PG8_STAGE
#undef PG8_LDA
#undef PG8_LDB
#undef PG8_MMA
#undef PG8_WAIT_V
#undef PG8_WAIT_L
#undef PG8_BAR
#undef PG8_SCHED
}
}

struct Params { const float* in[25]; float* out; unsigned char* ws; int ph_lo, ph_hi; };
enum { I_X = 0, I_C, I_WADA, I_BADA, I_N1G, I_WIN, I_MU, I_WDU, I_DBASE, I_WIU, I_IBASE, I_WGU, I_KKS, I_KMIX, I_RBON, I_LNW, I_LNB, I_FBIAS, I_WOA, I_WOB, I_WOUT, I_N2G, I_WFF1, I_WFF2, I_FG };

__device__ __forceinline__ void transpose_item(const float* __restrict__ W, int K, int Nsrc, int nblk, bf16_t* WT, LAS float* scr, int item, int lane, bool map) {
    const int kb = item / nblk, nb = item % nblk, k0 = 64 * kb, n0 = 32 * nb;
    const int n = n0 + (lane & 31); const int sc = map ? win_src_col(n) : n;
    float tv[32];
#pragma unroll
    for (int i = 0; i < 32; ++i) { const int kk = 2 * i + (lane >> 5); tv[i] = (sc >= 0) ? W[(size_t)(k0 + kk) * Nsrc + sc] : 0.f; }
#pragma unroll
    for (int i = 0; i < 32; ++i) { const int kk = 2 * i + (lane >> 5); scr[kk * 33 + (lane & 31)] = tv[i]; }
    LDS_WAIT();
    const int c = lane & 7;
#pragma unroll
    for (int j = 0; j < 4; ++j) { const int nn = (lane >> 3) + 8 * j; const LAS float* s = scr + (8 * c) * 33 + nn;
        u32x4 o; o.x = pk2(s[0 * 33], s[1 * 33]); o.y = pk2(s[2 * 33], s[3 * 33]); o.z = pk2(s[4 * 33], s[5 * 33]); o.w = pk2(s[6 * 33], s[7 * 33]);
        *(u32x4*)(WT + (size_t)(n0 + nn) * K + k0 + 8 * c) = o; }
    LDS_WAIT();
}

__device__ __forceinline__ void phase_p0(const Params& p, LAS unsigned char* lds) {
    const int tid = threadIdx.x, lane = tid & 63, wave = tid >> 6;
    const int gw = blockIdx.x * NWAVES + wave, NGW = gridDim.x * NWAVES;
    LAS float* scr = (LAS float*)(lds + wave * 8448);
    LAS float* cact = (LAS float*)(lds + 73728);
    for (int i = tid; i < NB * DM; i += NTHREADS) { const int b = i >> 10, k = i & 1023; const float c = p.in[I_C][i]; cact[k * 8 + b] = c / (1.f + __expf(-c)); }
    __syncthreads();
    unsigned char* ws = p.ws;
    {   bf16_t* WLR = (bf16_t*)(ws + WS_WLR);
        for (int i = blockIdx.x * NTHREADS + tid; i < 1536 * 256; i += gridDim.x * NTHREADS) {
            const int n = i >> 8, k = i & 255; float v = 0.f;
            if (n < 512) { if (k < 64) v = p.in[I_WDU][k * RW + n]; }
            else if (n < 1024) { if (k >= 64 && k < 128) v = p.in[I_WIU][(k - 64) * RW + (n - 512)]; }
            else { if (k >= 128) v = p.in[I_WGU][(k - 128) * RW + (n - 1024)]; }
            WLR[i] = (bf16_t)f2bf(v);
        } }
    constexpr int I_1 = 16 * 176, I_2 = 8 * 32, I_3 = 8 * 32, I_4 = 16 * 32, I_5 = 16 * 128, I_6 = 64 * 32, I_7 = NMOD / 32;
    constexpr int NITEMS = I_1 + I_2 + I_3 + I_4 + I_5 + I_6;
    for (int cb = blockIdx.x; cb < I_7; cb += gridDim.x) {
        LAS float* red = (LAS float*)(lds + 106496);
        const int col = 32 * cb + (lane & 31), kh = lane >> 5, kbase = 128 * wave + 64 * kh;
        float acc[8];
#pragma unroll
        for (int b = 0; b < 8; ++b) acc[b] = 0.f;
        const float* wp = p.in[I_WADA] + (size_t)kbase * NMOD + col;
#pragma unroll 16
        for (int i = 0; i < 64; ++i) {
            const float wv = wp[(size_t)i * NMOD];
            const f32x4 c0 = *(const LAS f32x4*)(cact + (kbase + i) * 8), c1 = *(const LAS f32x4*)(cact + (kbase + i) * 8 + 4);
            acc[0] += c0[0] * wv; acc[1] += c0[1] * wv; acc[2] += c0[2] * wv; acc[3] += c0[3] * wv;
            acc[4] += c1[0] * wv; acc[5] += c1[1] * wv; acc[6] += c1[2] * wv; acc[7] += c1[3] * wv;
        }
#pragma unroll
        for (int b = 0; b < 8; ++b) { const float sv = acc[b] + __shfl_xor(acc[b], 32); if (kh == 0) red[(wave * 8 + b) * 32 + (lane & 31)] = sv; }
        __syncthreads();
        if (tid < 256) { const int b = tid >> 5, c = tid & 31; float sv = 0.f;
#pragma unroll
            for (int w = 0; w < 8; ++w) sv += red[(w * 8 + b) * 32 + c];
            ((float*)(ws + WS_MOD))[b * NMOD + 32 * cb + c] = sv + p.in[I_BADA][32 * cb + c]; }
        __syncthreads();
    }
    for (int it = gw; it < NITEMS; it += NGW) {
        int r = it;
        if (r < I_1) { transpose_item(p.in[I_WIN], DM, N_IN, NPROJ / 32, (bf16_t*)(ws + WS_WIN), scr, r, lane, true); continue; } r -= I_1;
        if (r < I_2) { transpose_item(p.in[I_WOA], RW, DM, DM / 32, (bf16_t*)(ws + WS_WOA), scr, r, lane, false); continue; } r -= I_2;
        if (r < I_3) { transpose_item(p.in[I_WOB], RW, DM, DM / 32, (bf16_t*)(ws + WS_WOB), scr, r, lane, false); continue; } r -= I_3;
        if (r < I_4) { transpose_item(p.in[I_WOUT], DM, DM, DM / 32, (bf16_t*)(ws + WS_WOUT), scr, r, lane, false); continue; } r -= I_4;
        if (r < I_5) { transpose_item(p.in[I_WFF1], DM, DFF, DFF / 32, (bf16_t*)(ws + WS_WFF1), scr, r, lane, false); continue; } r -= I_5;
        transpose_item(p.in[I_WFF2], DFF, DM, DM / 32, (bf16_t*)(ws + WS_WFF2), scr, r, lane, false);
    }
}

template <int MODE, bool INB>
__device__ __forceinline__ void phase_norm(const float* X, const bf16_t* Xb, const float* g, const float* mod, int shoff, int scoff, bf16_t* Hout, float* Fout) {
    constexpr int R = 4;
    const int tid = threadIdx.x, lane = tid & 63, wave = tid >> 6;
    const int gw = blockIdx.x * NWAVES + wave, NGW = gridDim.x * NWAVES;
    f32x4 g4[4];
#pragma unroll
    for (int j = 0; j < 4; ++j) g4[j] = *(const f32x4*)(g + 4 * lane + 256 * j);
    for (int m0 = gw; m0 < T; m0 += R * NGW) {
        f32x4 v[R][4];
#pragma unroll
        for (int r = 0; r < R; ++r) {
            const int m = m0 + r * NGW; const int mm = (m < T) ? m : m0;
            if (INB) {
                const u32x2* xr = (const u32x2*)(Xb + (size_t)mm * DM) + lane;
#pragma unroll
                for (int j = 0; j < 4; ++j) { const u32x2 w = xr[64 * j]; v[r][j] = (f32x4){bflo(w.x), bfhi(w.x), bflo(w.y), bfhi(w.y)}; }
            } else {
                const f32x4* xr = (const f32x4*)(X + (size_t)mm * DM) + lane;
#pragma unroll
                for (int j = 0; j < 4; ++j) v[r][j] = xr[64 * j];
            }
        }
        float s[R];
#pragma unroll
        for (int r = 0; r < R; ++r) { s[r] = 0.f;
#pragma unroll
            for (int j = 0; j < 4; ++j) s[r] += (v[r][j].x * v[r][j].x + v[r][j].y * v[r][j].y) + (v[r][j].z * v[r][j].z + v[r][j].w * v[r][j].w); }
#pragma unroll
        for (int o = 1; o < 64; o <<= 1) {
#pragma unroll
            for (int r = 0; r < R; ++r) s[r] += __shfl_xor(s[r], o);
        }
#pragma unroll
        for (int r = 0; r < R; ++r) {
            const int m = m0 + r * NGW; if (m >= T) break;
            const float rstd = rsqrtf(s[r] * (1.f / DM) + NORM_EPS);
            const int b = m / SEQ;
#pragma unroll
            for (int j = 0; j < 4; ++j) {
                const int col = 4 * lane + 256 * j;
                f32x4 y = v[r][j] * rstd * g4[j];
                if (MODE == 0) {
                    const f32x4 sc = *(const f32x4*)(mod + (size_t)b * NMOD + scoff + col), sh = *(const f32x4*)(mod + (size_t)b * NMOD + shoff + col);
                    y = y * (sc + 1.f) + sh;
                    u32x2 o; o.x = pk2(y.x, y.y); o.y = pk2(y.z, y.w);
                    *(u32x2*)(Hout + (size_t)m * DM + col) = o;
                } else {
                    *(f32x4*)(Fout + (size_t)m * DM + col) = y;
                }
            }
        }
    }
}

__device__ __forceinline__ float logsigmoidf_(float x) { return fminf(x, 0.f) - log1pf(__expf(-fabsf(x))); }
__device__ __forceinline__ void unpack8(const u32x4 v, float* f) { f[0] = bflo(v.x); f[1] = bfhi(v.x); f[2] = bflo(v.y); f[3] = bfhi(v.y); f[4] = bflo(v.z); f[5] = bfhi(v.z); f[6] = bflo(v.w); f[7] = bfhi(v.w); }
__device__ __forceinline__ u32x4 pack8(const float* f) { u32x4 w; w.x = pk2(f[0], f[1]); w.y = pk2(f[2], f[3]); w.z = pk2(f[4], f[5]); w.w = pk2(f[6], f[7]); return w; }
__device__ __forceinline__ float sum8(float v) { v += __shfl_xor(v, 1); v += __shfl_xor(v, 2); v += __shfl_xor(v, 4); return v; }

__device__ __forceinline__ void phase_lrin(const Params& p, LAS unsigned char* lds) {
    const int gt = blockIdx.x * NTHREADS + threadIdx.x, NT = gridDim.x * NTHREADS;
    const bf16_t* PROJ = (const bf16_t*)(p.ws + WS_PROJ); bf16_t* LR = (bf16_t*)(p.ws + WS_LR);
    {
        const int g = gt & 31, col = C_WD + g * 8;
        const float* mup = p.in[I_MU] + win_src_col(col);
        const f32x4 m0 = *(const f32x4*)mup, m1 = *(const f32x4*)(mup + 4);
        const float mu[8] = {m0[0], m0[1], m0[2], m0[3], m1[0], m1[1], m1[2], m1[3]};
        constexpr int R = 4;
        for (int idx0 = gt; idx0 < T * 32; idx0 += R * NT) {
            u32x4 lc[R], lq[R];
#pragma unroll
            for (int r = 0; r < R; ++r) {
                const int idx = idx0 + r * NT; const int t = ((idx < T * 32) ? idx : idx0) >> 5;
                lc[r] = *(const u32x4*)(PROJ + (size_t)t * NPROJ + col);
                lq[r] = *(const u32x4*)(PROJ + (size_t)((t % SEQ == 0) ? t : t - 1) * NPROJ + col);
            }
#pragma unroll
            for (int r = 0; r < R; ++r) {
                const int idx = idx0 + r * NT; if (idx >= T * 32) break;
                const int t = idx >> 5;
                float c[8], q[8];
                unpack8(lc[r], c); unpack8(lq[r], q);
                if (t % SEQ == 0) {
#pragma unroll
                    for (int j = 0; j < 8; ++j) q[j] = 0.f;
                }
#pragma unroll
                for (int j = 0; j < 8; ++j) { const float v = c[j] + mu[j] * (q[j] - c[j]); c[j] = (g < 8) ? (1.f - 2.f / (1.f + __expf(2.f * v))) : ((g < 16) ? v : sigmoidf_(v)); }
                *(u32x4*)(LR + (size_t)t * 256 + g * 8) = pack8(c);
            }
        }
    }
    {   const int tid = threadIdx.x, lane = tid & 63, wave = tid >> 6;
        float* CUM = (float*)(p.ws + WS_CUM); LAS float* wtot = (LAS float*)lds;
        for (int bh = blockIdx.x; bh < NB * NH; bh += gridDim.x) {
            const int b = bh >> 3, h = bh & 7; const float fb = p.in[I_FBIAS][h];
            const int s0 = wave * 512 + lane * 8;
            const bf16_t* src = PROJ + (size_t)(b * SEQ + s0) * NPROJ + C_FL + h;
            float v[8];
#pragma unroll
            for (int i = 0; i < 8; ++i) v[i] = bf2f(src[(size_t)i * NPROJ]);
            float run = 0.f;
#pragma unroll
            for (int i = 0; i < 8; ++i) { run += logsigmoidf_(v[i] + fb); v[i] = run; }
            float inc = run;
#pragma unroll
            for (int o = 1; o < 64; o <<= 1) { const float n = __shfl_up(inc, o); if (lane >= o) inc += n; }
            if (lane == 63) wtot[wave] = inc;
            __syncthreads();
            float off = inc - run;
#pragma unroll
            for (int w2 = 0; w2 < 8; ++w2) off += (w2 < wave) ? wtot[w2] : 0.f;
            float* dst = CUM + (size_t)bh * SEQ + s0;
            *(f32x4*)dst = (f32x4){off + v[0], off + v[1], off + v[2], off + v[3]}; *(f32x4*)(dst + 4) = (f32x4){off + v[4], off + v[5], off + v[6], off + v[7]};
            __syncthreads();
        }
    }
}

__device__ __forceinline__ void phase_rkvab(const Params& p) {
    const int tid = threadIdx.x, lane = tid & 63, wave = tid >> 6;
    const int gt = blockIdx.x * NTHREADS + tid, NT = gridDim.x * NTHREADS;
    unsigned char* ws = p.ws;
    const bf16_t* PROJ = (const bf16_t*)(ws + WS_PROJ);
    bf16_t* Rb = (bf16_t*)p.out; bf16_t* Kb = Rb + (size_t)T * RW; bf16_t* Vb = Kb + (size_t)T * RW; bf16_t* Ab = Vb + (size_t)T * RW;
    bf16_t* Bb = (bf16_t*)(ws + WS_B);
    const int c = (gt & 63) * 8;
    float mur[8], muk[8], muv[8], kks[8], mix[8], rbn[8];
    float* BON = (float*)(ws + WS_BON);
#pragma unroll
    for (int j = 0; j < 8; ++j) { rbn[j] = p.in[I_RBON][c + j]; mur[j] = p.in[I_MU][c + j]; muk[j] = p.in[I_MU][576 + c + j]; muv[j] = p.in[I_MU][1088 + c + j]; kks[j] = p.in[I_KKS][c + j]; mix[j] = p.in[I_KMIX][c + j]; }
    for (int idx = gt; idx < T * 64; idx += NT) {
        const int t = idx >> 6; const bool first = (t % SEQ == 0);
        const bf16_t* row = PROJ + (size_t)t * NPROJ + c; const bf16_t* prow = row - NPROJ;
        float r[8], k[8], v[8], a[8], q[8];
        unpack8(*(const u32x4*)(row + C_R), r); unpack8(*(const u32x4*)(row + C_K), k); unpack8(*(const u32x4*)(row + C_V), v);
        const size_t o = (size_t)t * RW + c;
        unpack8(*(const u32x4*)(Bb + o), a);
        if (!first) {
            unpack8(*(const u32x4*)(prow + C_R), q);
#pragma unroll
            for (int j = 0; j < 8; ++j) r[j] += mur[j] * (q[j] - r[j]);
            unpack8(*(const u32x4*)(prow + C_K), q);
#pragma unroll
            for (int j = 0; j < 8; ++j) k[j] += muk[j] * (q[j] - k[j]);
            unpack8(*(const u32x4*)(prow + C_V), q);
#pragma unroll
            for (int j = 0; j < 8; ++j) v[j] += muv[j] * (q[j] - v[j]);
        } else {
#pragma unroll
            for (int j = 0; j < 8; ++j) { r[j] -= mur[j] * r[j]; k[j] -= muk[j] * k[j]; v[j] -= muv[j] * v[j]; }
        }
        float kk[8], ss = 0.f;
#pragma unroll
        for (int j = 0; j < 8; ++j) { kk[j] = k[j] * kks[j]; ss += kk[j] * kk[j]; }
        ss = sum8(ss);
        const float inv = 1.f / fmaxf(sqrtf(ss), 1e-12f);
        float av[8], bv[8], kp[8];
#pragma unroll
        for (int j = 0; j < 8; ++j) { kk[j] *= inv; av[j] = -kk[j]; bv[j] = kk[j] * a[j]; kp[j] = k[j] * (1.f + (a[j] - 1.f) * mix[j]); }
        float bs = 0.f;
#pragma unroll
        for (int j = 0; j < 8; ++j) bs += r[j] * kp[j] * rbn[j];
        bs = sum8(bs);
        if ((lane & 7) == 0) BON[(size_t)t * NH + (c >> 6)] = bs;
        *(u32x4*)(Rb + o) = pack8(r); *(u32x4*)(Kb + o) = pack8(kp); *(u32x4*)(Vb + o) = pack8(v); *(u32x4*)(Ab + o) = pack8(av); *(u32x4*)(Bb + o) = pack8(bv);
    }
}

typedef float f32x4_t __attribute__((ext_vector_type(4)));
__device__ __forceinline__ f32x4 mfma16(const u32x4 a, const u32x4 b, const f32x4 c) { return __builtin_amdgcn_mfma_f32_16x16x32_bf16(__builtin_bit_cast(bf16x8, a), __builtin_bit_cast(bf16x8, b), c, 0, 0, 0); }

__host__ __device__ constexpr int tri_off(int i) { return (i == 0) ? 0 : 4 * (2 * ((i - 1) >> 2) * (((i - 1) >> 2) + 1) + ((i - 1) - 4 * ((i - 1) >> 2)) * (((i - 1) >> 2) + 1)); }
static_assert(tri_off(1) == 0 && tri_off(2) == 4 && tri_off(5) == 16 && tri_off(6) == 24 && tri_off(64) == 2112, "tri_off");
__device__ __forceinline__ void phase_x1(const Params& p, LAS unsigned char* lds) {
    const int tid = threadIdx.x, lane = tid & 63, wave = __builtin_amdgcn_readfirstlane(tid >> 6);
    unsigned char* ws = p.ws;
    bf16_t* Rb = (bf16_t*)p.out; bf16_t* Kb = Rb + (size_t)T * RW; bf16_t* Ab = Rb + (size_t)3 * T * RW;
    bf16_t* Bb = (bf16_t*)(ws + WS_B); bf16_t* Wb = (bf16_t*)(ws + WS_W16);
    bf16_t* PROJ = (bf16_t*)(ws + WS_PROJ); float* DC = (float*)(ws + WS_DC);
    LAS bf16_t* OPS = (LAS bf16_t*)lds;
    LAS bf16_t* BKT = (LAS bf16_t*)(lds + 36864);
    LAS float* TOT = (LAS float*)(lds + 55296);
    LAS float* NB = (LAS float*)(lds + 57344);
    const int t = tid >> 3, jg = tid & 7;
    typedef _Float16 h8 __attribute__((ext_vector_type(8)));
    u32x4 lu, la, lr, lb, lk;
#define X1_ITEM(n_, it_, ok_) const int it_##g = blockIdx.x + ((n_) >> 3) * gridDim.x; const bool ok_ = it_##g < 512; const int it_ = it_##g * 8 + ((n_) & 7);
#define X1_LOAD(it_) do { const int bh_ = (it_) >> 6, c_ = (it_) & 63; const size_t o_ = ((size_t)(bh_ >> 3) * SEQ + c_ * 64 + t) * RW + (bh_ & 7) * 64 + 8 * jg; \
        lu = *(const u32x4*)(Wb + o_); la = *(const u32x4*)(Ab + o_); lr = *(const u32x4*)(Rb + o_); lb = *(const u32x4*)(Bb + o_); lk = *(const u32x4*)(Kb + o_); } while (0)
    { X1_ITEM(0, it0, ok0) if (ok0) X1_LOAD(it0); }
    for (int n = 0;; ++n) {
        X1_ITEM(n, it, ok) if (!ok) break;
        const int q = n & 7, grp = it >> 3;
        const int bh = it >> 6, c = it & 63, b = bh >> 3, h = bh & 7;
        const size_t base = (size_t)b * SEQ + c * 64; const int colh = h * 64;
        {
            float u[8], cs[8], av[8], rv[8], bv[8], kv[8];
            { const h8 hv = __builtin_bit_cast(h8, lu);
#pragma unroll
              for (int e = 0; e < 8; ++e) { u[e] = (float)hv[e]; cs[e] = u[e]; } }
            unpack8(la, av); unpack8(lr, rv); unpack8(lb, bv); unpack8(lk, kv);
#pragma unroll
            for (int d = 8; d < 64; d <<= 1) {
#pragma unroll
                for (int e = 0; e < 8; ++e) { const float nv = __shfl_up(cs[e], d); if (lane >= d) cs[e] += nv; }
            }
            if (lane >= 56) { *(LAS f32x4*)(TOT + wave * 64 + 8 * jg) = (f32x4){cs[0], cs[1], cs[2], cs[3]}; *(LAS f32x4*)(TOT + wave * 64 + 8 * jg + 4) = (f32x4){cs[4], cs[5], cs[6], cs[7]}; }
            LBAR();
            { X1_ITEM(n + 1, itn, okn) if (okn) X1_LOAD(itn); }
            float off[8], tot[8];
#pragma unroll
            for (int e = 0; e < 8; ++e) { off[e] = 0.f; tot[e] = 0.f; }
#pragma unroll
            for (int w2 = 0; w2 < 8; ++w2) { const f32x4 t0 = *(const LAS f32x4*)(TOT + w2 * 64 + 8 * jg), t1 = *(const LAS f32x4*)(TOT + w2 * 64 + 8 * jg + 4);
                const float sel = (w2 < wave) ? 1.f : 0.f;
#pragma unroll
                for (int e = 0; e < 4; ++e) { tot[e] += t0[e]; tot[4 + e] += t1[e]; off[e] += sel * t0[e]; off[4 + e] += sel * t1[e]; } }
            float at[8], rt[8], bt[8], kt[8];
#pragma unroll
            for (int e = 0; e < 8; ++e) {
                const float Lc = -(off[e] + cs[e]), Lp = Lc + u[e];
                const float e1 = __expf(Lp), e2 = __expf(Lc), e3 = __expf(-Lc), e4 = __expf(-tot[e] - Lc);
                at[e] = av[e] * e1; rt[e] = rv[e] * e2; bt[e] = bv[e] * e3; kt[e] = kv[e] * e3;
                BKT[(8 * jg + e) * 72 + (t ^ (8 * jg))] = (bf16_t)f2bf(bv[e] * e4); BKT[4608 + (8 * jg + e) * 72 + (t ^ (8 * jg))] = (bf16_t)f2bf(kv[e] * e4);
            }
            const u32x4 pa = pack8(at), pr = pack8(rt);
            *(LAS u32x4*)(OPS + t * 72 + 8 * jg) = pa; *(LAS u32x4*)(OPS + 4608 + t * 72 + 8 * jg) = pr;
            *(LAS u32x4*)(OPS + 2 * 4608 + t * 72 + 8 * jg) = pack8(bt); *(LAS u32x4*)(OPS + 3 * 4608 + t * 72 + 8 * jg) = pack8(kt);
            const size_t o = (base + t) * RW + colh + 8 * jg;
            *(u32x4*)(Ab + o) = pa; *(u32x4*)(Rb + o) = pr;
            if (t == 0) { float* dp = DC + (size_t)it * 64 + 8 * jg;
                *(f32x4*)dp = (f32x4){__expf(-tot[0]), __expf(-tot[1]), __expf(-tot[2]), __expf(-tot[3])}; *(f32x4*)(dp + 4) = (f32x4){__expf(-tot[4]), __expf(-tot[5]), __expf(-tot[6]), __expf(-tot[7])}; }
        }
        LBAR();
        {
            const int jr = tid >> 3, sg = (tid & 7) * 8; const size_t o = (base + jr) * RW + colh + sg;
            *(u32x4*)(Bb + o) = *(const LAS u32x4*)(BKT + jr * 72 + (sg ^ (8 * (jr >> 3))));
            *(u32x4*)(Kb + o) = *(const LAS u32x4*)(BKT + 4608 + jr * 72 + (sg ^ (8 * (jr >> 3))));
        }
        {
            const int mm = wave >> 1, half = wave & 1, m = lane & 15, kq = lane >> 4;
            const LAS bf16_t* Srow = OPS + ((mm & 1) ? 3 * 4608 : 2 * 4608);
            const LAS bf16_t* Trow = OPS + ((mm >= 2) ? 4608 : 0);
#pragma unroll
            for (int th = 0; th < 2; ++th) {
                const int tt = (half == 0) ? (th == 0 ? 0 : 3) : (th == 0 ? 1 : 2);
                const u32x4 bf0 = *(const LAS u32x4*)(Trow + (16 * tt + m) * 72 + kq * 8), bf1 = *(const LAS u32x4*)(Trow + (16 * tt + m) * 72 + kq * 8 + 32);
                const int tq = 16 * tt + m;
#pragma unroll
                for (int ts = 0; ts < 4; ++ts) {
                    f32x4 acc = {0.f, 0.f, 0.f, 0.f};
                    if (ts <= tt) {
                        const u32x4 af0 = *(const LAS u32x4*)(Srow + (16 * ts + m) * 72 + kq * 8), af1 = *(const LAS u32x4*)(Srow + (16 * ts + m) * 72 + kq * 8 + 32);
                        acc = mfma16(af0, bf0, acc); acc = mfma16(af1, bf1, acc);
                    }
                    const int s0 = 16 * ts + 4 * kq;
                    if (mm == 0) { if (s0 < tq) *(LAS f32x4*)(NB + q * 2112 + tri_off(tq) + s0) = acc; }
                    else {
                        float v[4];
#pragma unroll
                        for (int i = 0; i < 4; ++i) { const int sx = s0 + i; const bool keep = (mm == 1) ? (sx < tq) : (sx <= tq); v[i] = keep ? acc[i] : 0.f; }
                        u32x2 o; o.x = pk2(v[0], v[1]); o.y = pk2(v[2], v[3]);
                        if (mm == 1) *(u32x2*)(Wb + (base + tq) * RW + colh + s0) = o;
                        else if (mm == 2) *(u32x2*)(PROJ + (base + tq) * NPROJ + ((h < 4) ? C_WD + colh : C_FL + colh - 256) + s0) = o;
                        else *(u32x2*)(PROJ + (base + tq) * NPROJ + C_V + colh + s0) = o;
                    }
                }
            }
        }
        LBAR();
        if (q == 7) {
            {
                const int it4 = grp * 8 + wave, bh4 = it4 >> 6, c4 = it4 & 63;
                const size_t base4 = (size_t)(bh4 >> 3) * SEQ + c4 * 64;
                const LAS float* N = NB + wave * 2112; const int cc = lane;
                bf16_t* Td = PROJ + base4 * NPROJ + C_R + (bh4 & 7) * 64 + cc;
                float Tr[64];
#pragma unroll
                for (int i = 0; i < 64; ++i) {
                    float a0 = (cc == i) ? 1.f : 0.f, a1 = 0.f;
#pragma unroll
                    for (int j4 = 0; j4 < (i + 3) / 4; ++j4) {
                        const f32x4 nv = *(const LAS f32x4*)(N + tri_off(i) + 4 * j4);
#pragma unroll
                        for (int e = 0; e < 4; ++e) { const int j = 4 * j4 + e; if (j < i) { if (e & 1) a1 += nv[e] * Tr[j]; else a0 += nv[e] * Tr[j]; } }
                    }
                    Tr[i] = a0 + a1;
                    Td[(size_t)i * NPROJ] = (bf16_t)f2bf(Tr[i]);
                }
            }
            LBAR();
        }
    }
#undef X1_ITEM
#undef X1_LOAD
}

struct SOpsA { u32x4 at[2], aak[2]; f32x4 dc; };
struct SOpsB { u32x4 f[12]; };

__device__ __forceinline__ void phase_s(const Params& p, LAS unsigned char* lds) {
    const int tid = threadIdx.x, lane = tid & 63, wave = __builtin_amdgcn_readfirstlane(tid >> 6);
    unsigned char* ws = p.ws;
    const bf16_t* Rb = (const bf16_t*)p.out; const bf16_t* Kb = Rb + (size_t)T * RW; const bf16_t* Vb = Rb + (size_t)2 * T * RW; const bf16_t* Ab = Rb + (size_t)3 * T * RW;
    const bf16_t* Bb = (const bf16_t*)(ws + WS_B); const bf16_t* Wb = (const bf16_t*)(ws + WS_W16);
    const bf16_t* PROJ = (const bf16_t*)(ws + WS_PROJ); const float* DC = (const float*)(ws + WS_DC);
    unsigned char* PROJb = ws + WS_PROJ;
    LAS bf16_t* Ht = (LAS bf16_t*)lds;
    LAS bf16_t* Xt = (LAS bf16_t*)(lds + 18432);
    LAS bf16_t* Ut = (LAS bf16_t*)(lds + 27648);
    LAS bf16_t* Vt = (LAS bf16_t*)(lds + 36864);
    LAS unsigned char* BS = lds + 55296;
    const unsigned lo1 = (unsigned)(((lane & 15) * RW + (lane >> 4) * 8) * 2), lo2 = (unsigned)(((lane & 15) * NPROJ + (lane >> 4) * 8) * 2);
    const int m = lane & 15, kq = lane >> 4, cw = wave & 3;
    if (blockIdx.x < NB * NH) {
        const int bh = blockIdx.x;
        const int b = bh >> 3, h = bh & 7, colh = h * 64, arbcol = (h < 4) ? C_WD + colh : C_FL + colh - 256;
        const size_t rowb = (size_t)b * SEQ;
        const int ps = tid >> 3, pn = (tid & 7) * 8;
#define S_VLOAD(ch, S) do { va##S = *(const u32x4*)(Vb + (rowb + (size_t)(ch) * 64 + ps) * RW + colh + pn); } while (0)
#define S_VPUT(d, w_, e) do { (d)[(e) * 72] = (bf16_t)((w_) & 0xffffu); (d)[((e) + 1) * 72] = (bf16_t)((w_) >> 16); } while (0)
#define S_VWRITE(buf, S) do { LAS bf16_t* d_ = Vt + (buf) * 4608 + pn * 72 + ps; \
            S_VPUT(d_, va##S.x, 0); S_VPUT(d_, va##S.y, 2); S_VPUT(d_, va##S.z, 4); S_VPUT(d_, va##S.w, 6); } while (0)
#define S_UB(arr, pitch, ch, col) ((const char*)((arr) + (rowb + (size_t)(ch) * 64 + 16 * cw) * (pitch) + (col)))
#define S_OLOAD_A(o, ch) do { \
            _Pragma("unroll") for (int ks = 0; ks < 2; ++ks) { \
                (o).at[ks] = *(const u32x4*)(S_UB(Ab, RW, ch, colh + 32 * ks) + lo1); (o).aak[ks] = *(const u32x4*)(S_UB(Wb, RW, ch, colh + 32 * ks) + lo1); } \
            (o).dc = *(const f32x4*)(DC + ((size_t)bh * 64 + (ch)) * 64 + 16 * cw + 4 * kq); } while (0)
#define S_OLOAD_B(o, ch) do { \
            _Pragma("unroll") for (int ks = 0; ks < 2; ++ks) { \
                (o).f[ks] = *(const u32x4*)(S_UB(Rb, RW, ch, colh + 32 * ks) + lo1); \
                (o).f[2 + ks] = *(const u32x4*)(S_UB(PROJ, NPROJ, ch, arbcol + 32 * ks) + lo2); (o).f[4 + ks] = *(const u32x4*)(S_UB(PROJ, NPROJ, ch, C_V + colh + 32 * ks) + lo2); \
                (o).f[6 + ks] = *(const u32x4*)(S_UB(Bb, RW, ch, colh + 32 * ks) + lo1); (o).f[8 + ks] = *(const u32x4*)(S_UB(Kb, RW, ch, colh + 32 * ks) + lo1); \
                (o).f[10 + ks] = *(const u32x4*)(S_UB(PROJ, NPROJ, ch, C_R + colh + 32 * ks) + lo2); } } while (0)
#define S_BWRITE(o) do { _Pragma("unroll") for (int f_ = 0; f_ < 12; ++f_) *(LAS u32x4*)(BS + (cw * 12 + f_) * 1024 + lane * 16) = (o).f[f_]; } while (0)
#define S_BF(f_) (*(const LAS u32x4*)(BS + (cw * 12 + (f_)) * 1024 + lane * 16))
#define S_FRAG(BUF, nt, ks) (*(const LAS u32x4*)((BUF) + (16 * (nt) + m) * 72 + kq * 8 + 32 * (ks)))
#define S_PUT4(BUF, nt, v) do { u32x2 o_; o_.x = pk2((v)[0], (v)[1]); o_.y = pk2((v)[2], (v)[3]); *(LAS u32x2*)((BUF) + (16 * (nt) + m) * 72 + 16 * cw + 4 * kq) = o_; } while (0)
#define S_CHUNK(oa, ch, cur) do { \
            { f32x4 x[4]; \
              _Pragma("unroll") for (int nt = 0; nt < 4; ++nt) x[nt] = mfma16((oa).at[0], S_FRAG(Ht + (cur) * 4608, nt, 0), (f32x4){0.f, 0.f, 0.f, 0.f}); \
              _Pragma("unroll") for (int nt = 0; nt < 4; ++nt) x[nt] = mfma16((oa).at[1], S_FRAG(Ht + (cur) * 4608, nt, 1), x[nt]); \
              _Pragma("unroll") for (int nt = 0; nt < 4; ++nt) x[nt] = mfma16((oa).aak[0], S_FRAG(Vt + (cur) * 4608, nt, 0), x[nt]); \
              _Pragma("unroll") for (int nt = 0; nt < 4; ++nt) x[nt] = mfma16((oa).aak[1], S_FRAG(Vt + (cur) * 4608, nt, 1), x[nt]); \
              _Pragma("unroll") for (int nt = 0; nt < 4; ++nt) S_PUT4(Xt, nt, x[nt]); } \
            LBAR(); \
            { f32x4 u_[4]; const u32x4 f0 = S_BF(10), f1 = S_BF(11); \
              _Pragma("unroll") for (int nt = 0; nt < 4; ++nt) u_[nt] = mfma16(f0, S_FRAG(Xt, nt, 0), (f32x4){0.f, 0.f, 0.f, 0.f}); \
              _Pragma("unroll") for (int nt = 0; nt < 4; ++nt) u_[nt] = mfma16(f1, S_FRAG(Xt, nt, 1), u_[nt]); \
              _Pragma("unroll") for (int nt = 0; nt < 4; ++nt) S_PUT4(Ut, nt, u_[nt]); } \
            LBAR(); \
            { f32x4 y[4]; \
              { const u32x4 f0 = S_BF(0), f1 = S_BF(1); \
                _Pragma("unroll") for (int nt = 0; nt < 4; ++nt) y[nt] = mfma16(f0, S_FRAG(Ht + (cur) * 4608, nt, 0), (f32x4){0.f, 0.f, 0.f, 0.f}); \
                _Pragma("unroll") for (int nt = 0; nt < 4; ++nt) y[nt] = mfma16(f1, S_FRAG(Ht + (cur) * 4608, nt, 1), y[nt]); } \
              { const u32x4 f0 = S_BF(2), f1 = S_BF(3); \
                _Pragma("unroll") for (int nt = 0; nt < 4; ++nt) y[nt] = mfma16(f0, S_FRAG(Ut, nt, 0), y[nt]); \
                _Pragma("unroll") for (int nt = 0; nt < 4; ++nt) y[nt] = mfma16(f1, S_FRAG(Ut, nt, 1), y[nt]); } \
              { const u32x4 f0 = S_BF(4), f1 = S_BF(5); \
                _Pragma("unroll") for (int nt = 0; nt < 4; ++nt) y[nt] = mfma16(f0, S_FRAG(Vt + (cur) * 4608, nt, 0), y[nt]); \
                _Pragma("unroll") for (int nt = 0; nt < 4; ++nt) y[nt] = mfma16(f1, S_FRAG(Vt + (cur) * 4608, nt, 1), y[nt]); } \
              bf16_t* ybase_ = (bf16_t*)PROJb + (rowb + (size_t)(ch) * 64 + 16 * cw + 4 * kq) * (size_t)NPROJ + C_K + colh + m; \
              _Pragma("unroll") for (int nt = 0; nt < 4; ++nt) _Pragma("unroll") for (int i = 0; i < 4; ++i) ybase_[(size_t)i * NPROJ + 16 * nt] = (bf16_t)f2bf(y[nt][i]); } \
            _Pragma("unroll") for (int nt = 0; nt < 4; ++nt) hreg[nt] = hreg[nt] * (oa).dc; \
            { const u32x4 f0 = S_BF(6), f1 = S_BF(7); \
              _Pragma("unroll") for (int nt = 0; nt < 4; ++nt) hreg[nt] = mfma16(f0, S_FRAG(Ut, nt, 0), hreg[nt]); \
              _Pragma("unroll") for (int nt = 0; nt < 4; ++nt) hreg[nt] = mfma16(f1, S_FRAG(Ut, nt, 1), hreg[nt]); } \
            { const u32x4 f0 = S_BF(8), f1 = S_BF(9); \
              _Pragma("unroll") for (int nt = 0; nt < 4; ++nt) hreg[nt] = mfma16(f0, S_FRAG(Vt + (cur) * 4608, nt, 0), hreg[nt]); \
              _Pragma("unroll") for (int nt = 0; nt < 4; ++nt) hreg[nt] = mfma16(f1, S_FRAG(Vt + (cur) * 4608, nt, 1), hreg[nt]); } \
            _Pragma("unroll") for (int nt = 0; nt < 4; ++nt) S_PUT4(Ht + ((cur) ^ 1) * 4608, nt, hreg[nt]); \
            LBAR(); } while (0)
#define S_CONSV(ch, VN, cur) do { if ((ch) + 1 < 64) S_VWRITE((cur) ^ 1, VN); if ((ch) + 4 < 64) S_VLOAD((ch) + 4, VN); } while (0)
#define S_PROD(ch, BC, BN, VN, cur) do { \
            if ((ch) + 2 < 64) S_OLOAD_B(BN, (ch) + 2); \
            S_BWRITE(BC); S_CONSV(ch, VN, cur); \
            LBAR(); LBAR(); LBAR(); } while (0)
        for (int i = tid; i < 2304; i += NTHREADS) ((LAS unsigned*)Ht)[i] = 0u;
        if (wave >= 4) {
            SOpsB b0, b1, b2; u32x4 va0, va1, va2;
            S_VLOAD(0, 0); S_OLOAD_B(b0, 0); S_OLOAD_B(b1, 1); S_VWRITE(0, 0); S_VLOAD(1, 1); S_VLOAD(2, 2); S_VLOAD(3, 0);
            LBAR();
            for (int ch = 0; ch < 63; ch += 3) {
                S_PROD(ch,     b0, b2, 1, ch & 1);
                S_PROD(ch + 1, b1, b0, 2, (ch + 1) & 1);
                S_PROD(ch + 2, b2, b1, 0, ch & 1);
            }
            S_PROD(63, b0, b2, 1, 1);
        } else {
            SOpsA a0, a1, a2; u32x4 va0, va1, va2;
            f32x4 hreg[4];
#pragma unroll
            for (int nt = 0; nt < 4; ++nt) hreg[nt] = (f32x4){0.f, 0.f, 0.f, 0.f};
            S_VLOAD(0, 0); S_OLOAD_A(a0, 0); S_OLOAD_A(a1, 1); S_VWRITE(0, 0); S_VLOAD(1, 1); S_VLOAD(2, 2); S_VLOAD(3, 0);
            LBAR();
            for (int ch = 0; ch < 63; ch += 3) {
                S_OLOAD_A(a2, ch + 2);                      S_CONSV(ch,     1, ch & 1);       S_CHUNK(a0, ch, ch & 1);
                S_OLOAD_A(a0, ch + 3);                      S_CONSV(ch + 1, 2, (ch + 1) & 1); S_CHUNK(a1, ch + 1, (ch + 1) & 1);
                if (ch + 4 < 64) S_OLOAD_A(a1, ch + 4);     S_CONSV(ch + 2, 0, ch & 1);       S_CHUNK(a2, ch + 2, ch & 1);
            }
            S_CONSV(63, 1, 1); S_CHUNK(a0, 63, 1);
        }
        LBAR();
#undef S_VLOAD
#undef S_VPUT
#undef S_VWRITE
#undef S_UB
#undef S_OLOAD_A
#undef S_OLOAD_B
#undef S_BWRITE
#undef S_BF
#undef S_FRAG
#undef S_PUT4
#undef S_CHUNK
#undef S_PROD
#undef S_CONSV
    }
}

__device__ __forceinline__ float max3f_(float a, float b, float c) { float r; asm("v_max3_f32 %0, %1, %2, %3" : "=v"(r) : "v"(a), "v"(b), "v"(c)); return r; }
__device__ __forceinline__ int crow(int r, int hi) { return (r & 3) + 8 * (r >> 2) + 4 * hi; }

__device__ __forceinline__ void attn_unit(const Params& p, LAS unsigned char* lds, int b, int h, int qb) {
    constexpr int BUFB = 36352, KOFF = 0, VOFF = 18432, BOFF = 35840, VS = 136;
    constexpr float C2 = 0.125f * LOG2E;
    const int tid = threadIdx.x, lane = tid & 63, wave = __builtin_amdgcn_readfirstlane(tid >> 6), r32 = lane & 31, hi = lane >> 5;
    bf16_t* PROJ = (bf16_t*)(p.ws + WS_PROJ);
    const float* cumg = (const float*)(p.ws + WS_CUM) + (size_t)(b * NH + h) * SEQ;
    const size_t rowbase = (size_t)b * SEQ; const int q0 = qb * 256, qw = q0 + wave * 32;
    bf16x8 qr[4];
    {   const bf16_t* Qp = PROJ + (rowbase + qw + r32) * NPROJ + C_FQ + h * 64;
#pragma unroll
        for (int d0 = 0; d0 < 4; ++d0) qr[d0] = *(const bf16x8*)(Qp + d0 * 16 + hi * 8); }
    const bf16_t* Kg = PROJ + rowbase * NPROJ + C_FK + h * 64; const bf16_t* Vg = PROJ + rowbase * NPROJ + C_FV + h * 64;
    const int NS = (q0 + 256) / 128;
    const int lkey = tid >> 3, d8 = (tid & 7) * 8;
    u32x4 ka0_, kb0_, va0_, vb0_, ka1_, kb1_, va1_, vb1_; float bias0_ = 0.f, bias1_ = 0.f;
#define ATT_LOAD(st, S) do { const size_t k0_ = (size_t)(st) * 128; \
        ka##S##_ = *(const u32x4*)(Kg + (k0_ + lkey) * NPROJ + d8); kb##S##_ = *(const u32x4*)(Kg + (k0_ + 64 + lkey) * NPROJ + d8); \
        va##S##_ = *(const u32x4*)(Vg + (k0_ + lane) * NPROJ + wave * 8); vb##S##_ = *(const u32x4*)(Vg + (k0_ + 64 + lane) * NPROJ + wave * 8); \
        if (tid < 128) bias##S##_ = -cumg[(st) * 128 + tid] * LOG2E; } while (0)
#define ATT_VPUT(vt, v) do { (vt)[0] = (bf16_t)((v).x & 0xffffu); (vt)[VS] = (bf16_t)((v).x >> 16); (vt)[2 * VS] = (bf16_t)((v).y & 0xffffu); (vt)[3 * VS] = (bf16_t)((v).y >> 16); \
        (vt)[4 * VS] = (bf16_t)((v).z & 0xffffu); (vt)[5 * VS] = (bf16_t)((v).z >> 16); (vt)[6 * VS] = (bf16_t)((v).w & 0xffffu); (vt)[7 * VS] = (bf16_t)((v).w >> 16); } while (0)
#define ATT_WRITE(cb, S) do { LAS unsigned char* B_ = lds + (cb) * BUFB; \
        *(LAS u32x4*)(B_ + KOFF + lkey * 144 + d8 * 2) = ka##S##_; *(LAS u32x4*)(B_ + KOFF + (64 + lkey) * 144 + d8 * 2) = kb##S##_; \
        LAS bf16_t* vt_ = (LAS bf16_t*)(B_ + VOFF) + (wave * 8) * VS + lane;     \
        ATT_VPUT(vt_, va##S##_); ATT_VPUT(vt_ + 64, vb##S##_); \
        if (tid < 128) ((LAS float*)(B_ + BOFF))[tid] = bias##S##_; } while (0)
    ATT_LOAD(0, 0); ATT_LOAD(1, 1); ATT_WRITE(0, 0);
    LBAR();
    float m = -1e30f, l = 0.f; f32x16 o[2];
#pragma unroll
    for (int r = 0; r < 16; ++r) { o[0][r] = 0.f; o[1][r] = 0.f; }
    for (int s2 = 0; s2 < NS; s2 += 2) {
#pragma unroll
      for (int js = 0; js < 2; ++js) {
        const int st = s2 + js, cb = js;
        if (st + 2 < NS) { if (js == 0) ATT_LOAD(st + 2, 0); else ATT_LOAD(st + 2, 1); }
#pragma unroll
        for (int sub = 0; sub < 2; ++sub) {
          const int kt = 2 * st + sub;
          if (kt * 64 <= qw + 31) {
            const LAS unsigned char* Bf = lds + cb * BUFB;
            f32x16 p0, p1;
#pragma unroll
            for (int r = 0; r < 16; ++r) { p0[r] = 0.f; p1[r] = 0.f; }
#pragma unroll
            for (int d0 = 0; d0 < 4; ++d0) {
                const bf16x8 ka0 = *(const LAS bf16x8*)(Bf + KOFF + (sub * 64 + r32) * 144 + (d0 * 16 + hi * 8) * 2);
                const bf16x8 ka1 = *(const LAS bf16x8*)(Bf + KOFF + (sub * 64 + 32 + r32) * 144 + (d0 * 16 + hi * 8) * 2);
                p0 = __builtin_amdgcn_mfma_f32_32x32x16_bf16(ka0, qr[d0], p0, 0, 0, 0);
                p1 = __builtin_amdgcn_mfma_f32_32x32x16_bf16(ka1, qr[d0], p1, 0, 0, 0);
            }
            const LAS float* kbp = (const LAS float*)(Bf + BOFF) + sub * 64;
#pragma unroll
            for (int g = 0; g < 4; ++g) {
                const f32x4 kb0 = *(const LAS f32x4*)(kbp + 8 * g + 4 * hi), kb1 = *(const LAS f32x4*)(kbp + 32 + 8 * g + 4 * hi);
#pragma unroll
                for (int j = 0; j < 4; ++j) { p0[4 * g + j] = p0[4 * g + j] * C2 + kb0[j]; p1[4 * g + j] = p1[4 * g + j] * C2 + kb1[j]; }
            }
            if (kt * 64 + 63 > qw) {
                asm volatile("" ::: "memory");
                const int qrel = qw + r32 - kt * 64;
#pragma unroll
                for (int r = 0; r < 16; ++r) { const int key = crow(r, hi); if (key > qrel) p0[r] = -INFINITY; if (key + 32 > qrel) p1[r] = -INFINITY; }
                asm volatile("" ::: "memory");
            }
            float rm = max3f_(p0[0], p1[0], p0[1]);
            rm = max3f_(rm, p1[1], p0[2]);
#pragma unroll
            for (int r = 2; r < 15; ++r) rm = max3f_(rm, p1[r], p0[r + 1]);
            rm = fmaxf(rm, p1[15]);
            { const auto rr = __builtin_amdgcn_permlane32_swap(__float_as_uint(rm), __float_as_uint(rm), false, false); rm = fmaxf(__uint_as_float(rr[0]), __uint_as_float(rr[1])); }
            const float mnew = fmaxf(m, rm), alpha = __builtin_amdgcn_exp2f(m - mnew); m = mnew;
            float rs = 0.f;
#pragma unroll
            for (int r = 0; r < 16; ++r) { p0[r] = __builtin_amdgcn_exp2f(p0[r] - mnew); p1[r] = __builtin_amdgcn_exp2f(p1[r] - mnew); rs += p0[r] + p1[r]; }
            l = l * alpha + rs;
#pragma unroll
            for (int r = 0; r < 16; ++r) { o[0][r] *= alpha; o[1][r] *= alpha; }
            u32x4 pw[4];
            pw[0] = (u32x4){pk2(p0[0], p0[1]), pk2(p0[2], p0[3]), pk2(p0[4], p0[5]), pk2(p0[6], p0[7])};
            pw[1] = (u32x4){pk2(p0[8], p0[9]), pk2(p0[10], p0[11]), pk2(p0[12], p0[13]), pk2(p0[14], p0[15])};
            pw[2] = (u32x4){pk2(p1[0], p1[1]), pk2(p1[2], p1[3]), pk2(p1[4], p1[5]), pk2(p1[6], p1[7])};
            pw[3] = (u32x4){pk2(p1[8], p1[9]), pk2(p1[10], p1[11]), pk2(p1[12], p1[13]), pk2(p1[14], p1[15])};
#pragma unroll
            for (int sl = 0; sl < 4; ++sl)
#pragma unroll
                for (int d0 = 0; d0 < 2; ++d0) {
                    const int base = sub * 64 + 32 * (sl >> 1) + 16 * (sl & 1) + 4 * hi;
                    const LAS unsigned char* vp = Bf + VOFF + (d0 * 32 + r32) * (VS * 2) + base * 2;
                    const u32x2 lo = *(const LAS u32x2*)vp, hh = *(const LAS u32x2*)(vp + 16);
                    const u32x4 vv = {lo.x, lo.y, hh.x, hh.y};
                    o[d0] = __builtin_amdgcn_mfma_f32_32x32x16_bf16(__builtin_bit_cast(bf16x8, vv), __builtin_bit_cast(bf16x8, pw[sl]), o[d0], 0, 0, 0);
                }
          }
        }
        if (st + 1 < NS) { if (js == 0) ATT_WRITE(1, 1); else ATT_WRITE(0, 0); }
        LBAR();
      }
    }
#undef ATT_LOAD
#undef ATT_VPUT
#undef ATT_WRITE
    { const auto rr = __builtin_amdgcn_permlane32_swap(__float_as_uint(l), __float_as_uint(l), false, false); l = __uint_as_float(rr[0]) + __uint_as_float(rr[1]); }
    const float rl = 1.f / l;
    bf16_t* Op = PROJ + (rowbase + qw + r32) * NPROJ + C_FQ + h * 64 + 4 * hi;
#pragma unroll
    for (int d0 = 0; d0 < 2; ++d0)
#pragma unroll
        for (int g = 0; g < 4; ++g) { u32x2 ov; ov.x = pk2(o[d0][4 * g] * rl, o[d0][4 * g + 1] * rl); ov.y = pk2(o[d0][4 * g + 2] * rl, o[d0][4 * g + 3] * rl);
            *(u32x2*)(Op + d0 * 32 + 8 * g) = ov; }
}

__device__ __forceinline__ void phase_attn(const Params& p, LAS unsigned char* lds) {
    unsigned* ctr = (unsigned*)(p.ws + WS_CTL) + 3600;
    volatile LAS unsigned* slot = (volatile LAS unsigned*)(lds + 131088);
    for (;;) {
        __syncthreads();
        if (threadIdx.x == 0) *slot = atomicAdd(ctr, 1u);
        __syncthreads();
        const unsigned u = *slot;
        if (u >= 1024u) break;
        const int qb = 15 - (int)(u >> 6), bh = (int)(u & 63u);
        attn_unit(p, lds, bh >> 3, bh & 7, qb);
    }
}

__device__ __forceinline__ void phase_fin(const Params& p) {
    const int gt = blockIdx.x * NTHREADS + threadIdx.x, NT = gridDim.x * NTHREADS;
    unsigned char* ws = p.ws;
    const bf16_t* Vb = (const bf16_t*)p.out + (size_t)2 * T * RW;
    const bf16_t* Gb = (const bf16_t*)(ws + WS_G); const float* BON = (const float*)(ws + WS_BON);
    unsigned char* PROJb = ws + WS_PROJ;
    const int c = (gt & 63) * 8;
    float lnw[8], lnb[8];
#pragma unroll
    for (int j = 0; j < 8; ++j) { lnw[j] = p.in[I_LNW][c + j]; lnb[j] = p.in[I_LNB][c + j]; }
    constexpr int R = 4;
    for (int idx0 = gt; idx0 < T * 64; idx0 += R * NT) {
        u32x4 ly[R], lv[R], lg[R]; float lb[R];
#pragma unroll
        for (int r = 0; r < R; ++r) {
            const int idx = idx0 + r * NT; const int t = ((idx < T * 64) ? idx : idx0) >> 6; const size_t o = (size_t)t * RW + c;
            ly[r] = *(const u32x4*)((const bf16_t*)PROJb + (size_t)t * NPROJ + C_K + c); lv[r] = *(const u32x4*)(Vb + o); lg[r] = *(const u32x4*)(Gb + o);
            lb[r] = BON[(size_t)t * NH + (c >> 6)];
        }
#pragma unroll
        for (int r = 0; r < R; ++r) {
            const int idx = idx0 + r * NT; if (idx >= T * 64) break;
            const int t = idx >> 6;
            float y[8], v[8], g[8];
            unpack8(ly[r], y); unpack8(lv[r], v); unpack8(lg[r], g);
            const float sb = lb[r];
            float s1 = 0.f;
#pragma unroll
            for (int j = 0; j < 8; ++j) s1 += y[j];
            s1 = sum8(s1);
            const float mean = s1 * (1.f / 64.f);
            float s2 = 0.f;
#pragma unroll
            for (int j = 0; j < 8; ++j) { y[j] -= mean; s2 += y[j] * y[j]; }
            s2 = sum8(s2);
            const float rstd = rsqrtf(s2 * (1.f / 64.f) + GN_EPS);
#pragma unroll
            for (int j = 0; j < 8; ++j) y[j] = ((y[j] * rstd * lnw[j] + lnb[j]) + sb * v[j]) * g[j];
            *(u32x4*)((bf16_t*)PROJb + (size_t)t * NPROJ + C_R + c) = pack8(y);
        }
    }
}

#define XB_TMO      128
#define XB_XCNT(j)  (256  + 64 * (j))
#define XB_XSUB(j)  (1280 + 64 * (j))
#define XB_XGEN(j)  (2304 + 64 * (j))
#define XB_TOP      3328
#define XB_TOPGEN   3392
#define XCD_BAR_WORDS 3456
#define XB_SPIN_CAP (1u << 18)

__device__ __forceinline__ unsigned xb_ld(unsigned* p)              { return __hip_atomic_load(p, __ATOMIC_RELAXED, __HIP_MEMORY_SCOPE_AGENT); }
__device__ __forceinline__ unsigned xb_add(unsigned* p, unsigned v) { return __hip_atomic_fetch_add(p, v, __ATOMIC_RELAXED, __HIP_MEMORY_SCOPE_AGENT); }
__device__ __forceinline__ unsigned xb_xcc_id() { return (unsigned)__builtin_amdgcn_s_getreg((3 << 11) | 20) & 0xFu; }
#define XB_SPIN(cond, bar) do { unsigned _sp = 0; while (cond) { __builtin_amdgcn_s_sleep(1); \
    if ((++_sp & 255u) == 0u) { if (xb_ld(&(bar)[XB_TMO])) break; if (_sp > XB_SPIN_CAP) { atomicAdd(&(bar)[XB_TMO], 1u); break; } } } } while (0)

struct XcdBarrier {
    unsigned* bar; unsigned x;
    volatile LAS unsigned* st;
};

__device__ __forceinline__ XcdBarrier xcd_barrier_post(unsigned* bar, volatile LAS unsigned* st) {
    XcdBarrier b; b.bar = bar; b.x = xb_xcc_id(); b.st = st;
    if (threadIdx.x == 0) (void)xb_add(&bar[XB_XCNT(b.x)], 1u);
    return b;
}
__device__ __forceinline__ void xcd_barrier_complete(unsigned* bar, unsigned x, unsigned& nloc, unsigned& nx) {
    const unsigned G = gridDim.x * gridDim.y * gridDim.z;
    unsigned sum, cnt, mine, sp = 0u;
    for (;;) {
        sum = 0u; cnt = 0u; mine = 0u;
#pragma unroll
        for (unsigned j = 0; j < 16; ++j) { const unsigned c = xb_ld(&bar[XB_XCNT(j)]); sum += c; cnt += (c > 0u) ? 1u : 0u; mine = (j == x) ? c : mine; }
        if (sum == G) break;
        __builtin_amdgcn_s_sleep(1);
        if ((++sp & 255u) == 0u) { if (xb_ld(&bar[XB_TMO])) break; if (sp > XB_SPIN_CAP) { atomicAdd(&bar[XB_TMO], 1u); break; } }
    }
    nloc = mine > 0u ? mine : 1u; nx = cnt > 0u ? cnt : 1u;
}

__device__ __forceinline__ void xcd_barrier(const XcdBarrier& b) {
    asm volatile("s_waitcnt vmcnt(0)" ::: "memory");
    __syncthreads();
    if (threadIdx.x == 0) {
        unsigned* bar = b.bar;
        __builtin_amdgcn_s_waitcnt(0);
        unsigned nloc = b.st[0], nx = b.st[1];
        if (nloc == 0u) { xcd_barrier_complete(bar, b.x, nloc, nx); b.st[0] = nloc; b.st[1] = nx; }
        const unsigned old = xb_add(&bar[XB_XSUB(b.x)], 1u);
        const unsigned gen = old / nloc;
        if (old + 1u == (gen + 1u) * nloc) {
            __builtin_amdgcn_fence(__ATOMIC_RELEASE, "agent");
            asm volatile("s_waitcnt vmcnt(0)" ::: "memory");
            const unsigned og = xb_add(&bar[XB_TOP], 1u);
            const unsigned tg = og / nx;
            if (og + 1u == (tg + 1u) * nx) xb_add(&bar[XB_TOPGEN], 1u);
            else XB_SPIN(xb_ld(&bar[XB_TOPGEN]) == tg, bar);
            __builtin_amdgcn_fence(__ATOMIC_ACQUIRE, "agent");
            xb_add(&bar[XB_XGEN(b.x)], 1u);
            asm volatile("s_waitcnt vmcnt(0)" ::: "memory");
        } else {
            XB_SPIN(xb_ld(&bar[XB_XGEN(b.x)]) == gen, bar);
            __builtin_amdgcn_fence(__ATOMIC_ACQUIRE, "agent");
            asm volatile("s_waitcnt vmcnt(0)" ::: "memory");
        }
    }
    __syncthreads();
}


#ifndef PROBE_PHASE
#define PROBE_PHASE -1
#endif
#ifndef PROBE_SYNCS
#define PROBE_SYNCS 0
#endif
#ifndef PROBE_MULT
#define PROBE_MULT 3
#endif
#define PROBE_T0(k) unsigned long long _pt0 = 0; if (PROBE_PHASE == (k)) _pt0 = __builtin_amdgcn_s_memrealtime();
#define PROBE_T1(k) if (PROBE_PHASE == (k)) { __syncthreads(); const unsigned long long _t1 = __builtin_amdgcn_s_memrealtime(); const unsigned long long _end = _t1 + PROBE_MULT * (_t1 - _pt0); while (__builtin_amdgcn_s_memrealtime() < _end) __builtin_amdgcn_s_sleep(16); }
__global__ void __launch_bounds__(NTHREADS, 2) fwd_kernel(Params p) {
    extern __shared__ __attribute__((aligned(16))) unsigned char lds_raw[];
    LAS unsigned char* lds = (LAS unsigned char*)lds_raw;
    cg::grid_group grid = cg::this_grid();
    const int lo = p.ph_lo, hi = p.ph_hi;
    volatile LAS unsigned* bst = (volatile LAS unsigned*)(lds + 131072);
    if (hi - lo > 1) { if (threadIdx.x < 2) bst[threadIdx.x] = 0u; __syncthreads(); (void)xcd_barrier_post((unsigned*)(p.ws + WS_CTL), bst); }
    if (hi < 0) grid.sync();
    unsigned char* ws = p.ws;
    float* mod = (float*)(ws + WS_MOD);
    bf16_t* PROJ = (bf16_t*)(ws + WS_PROJ);
    const int G = gridDim.x, bx = blockIdx.x;
#define IN(k) (lo <= (k) && (k) < hi)
#define SEAM(k) do { if (IN(k) && IN((k) + 1)) { XcdBarrier xb_; xb_.bar = (unsigned*)(p.ws + WS_CTL); xb_.x = xb_xcc_id(); xb_.st = (volatile LAS unsigned*)(lds + 131072); xcd_barrier(xb_); } } while (0)
    if (IN(0)) { PROBE_T0(0) phase_p0(p, lds); PROBE_T1(0) } SEAM(0);
    if (IN(1)) { PROBE_T0(1) phase_norm<0, false>(p.in[I_X], nullptr, p.in[I_N1G], mod, 0, 1024, (bf16_t*)(ws + WS_H), nullptr); PROBE_T1(1) } SEAM(1);
    if (IN(2)) { PROBE_T0(2)
        pg8::Gemm g{(const bf16_t*)(ws + WS_H), (const bf16_t*)(ws + WS_WIN), T, NPROJ, DM, DM}; pg8::StaticOrder S; S.init(T, NPROJ, G, bx);
        pg8::Epi<0> E{PROJ, NPROJ, nullptr, nullptr, nullptr, nullptr, 0};
        pg8::gemm_phase(lds, g, S, E);
    PROBE_T1(2) } SEAM(2);
    if (IN(3)) { PROBE_T0(3) phase_lrin(p, lds); PROBE_T1(3) } SEAM(3);
    if (IN(4)) { PROBE_T0(4)
        pg8::Gemm g{(const bf16_t*)(ws + WS_LR), (const bf16_t*)(ws + WS_WLR), T, 1536, 256, 256}; pg8::StaticOrder S; S.init(T, 1536, G, bx);
        pg8::Epi<5> E{(bf16_t*)(ws + WS_AI), RW, nullptr, p.in[I_DBASE], p.in[I_IBASE], nullptr, 0, (bf16_t*)(ws + WS_W16), (bf16_t*)(ws + WS_G)};
        pg8::gemm_phase(lds, g, S, E);
    PROBE_T1(4) } SEAM(4);
    if (IN(5)) { PROBE_T0(5) phase_rkvab(p); PROBE_T1(5) } SEAM(5);
    if (IN(6)) { PROBE_T0(6) phase_x1(p, lds); PROBE_T1(6) } SEAM(6);
    if (IN(7)) { PROBE_T0(7) phase_s(p, lds); PROBE_T1(7) }
    if (IN(8)) { PROBE_T0(8) phase_attn(p, lds); PROBE_T1(8) } SEAM(8);
    if (IN(9)) { PROBE_T0(9) phase_fin(p); PROBE_T1(9) } SEAM(9);
    if (IN(10)) { PROBE_T0(10)
        {   pg8::Gemm g{PROJ + C_R, (const bf16_t*)(ws + WS_WOA), T, DM, RW, NPROJ}; pg8::StaticOrder S; S.init(T, DM, G, bx);
            pg8::Epi<2> E{(bf16_t*)(ws + WS_H), DM, nullptr, nullptr, nullptr, PROJ, C_GA};
            pg8::gemm_phase(lds, g, S, E); }
        {   pg8::Gemm g{PROJ + C_FQ, (const bf16_t*)(ws + WS_WOB), T, DM, RW, NPROJ}; pg8::StaticOrder S; S.init(T, DM, G, bx);
            pg8::Epi<3> E{(bf16_t*)(ws + WS_H), DM, nullptr, nullptr, nullptr, PROJ, C_GB};
            pg8::gemm_phase(lds, g, S, E); }
    PROBE_T1(10) } SEAM(10);
    if (IN(11)) { PROBE_T0(11)
        pg8::Gemm g{(const bf16_t*)(ws + WS_H), (const bf16_t*)(ws + WS_WOUT), T, DM, DM, DM}; pg8::StaticOrder S; S.init(T, DM, G, bx);
        pg8::Epi<7> E{(bf16_t*)(ws + WS_X1B), DM, nullptr, p.in[I_X], mod + 2048, nullptr, 0};
        pg8::gemm_phase(lds, g, S, E);
    PROBE_T1(11) } SEAM(11);
    if (IN(12)) { PROBE_T0(12) phase_norm<0, true>(nullptr, (const bf16_t*)(ws + WS_X1B), p.in[I_N2G], mod, 3072, 4096, (bf16_t*)(ws + WS_H), nullptr); PROBE_T1(12) } SEAM(12);
    if (IN(13)) { PROBE_T0(13)
        pg8::Gemm g{(const bf16_t*)(ws + WS_H), (const bf16_t*)(ws + WS_WFF1), T, DFF, DM, DM}; pg8::StaticOrder S; S.init(T, DFF, G, bx);
        pg8::Epi<1> E{PROJ, DFF, nullptr, nullptr, nullptr, nullptr, 0};
        pg8::gemm_phase(lds, g, S, E);
    PROBE_T1(13) } SEAM(13);
    if (IN(14)) { PROBE_T0(14)
        pg8::Gemm g{PROJ, (const bf16_t*)(ws + WS_WFF2), T, DM, DFF, DFF}; pg8::StaticOrder S; S.init(T, DM, G, bx);
        pg8::Epi<8> E{(bf16_t*)(ws + WS_H), DM, nullptr, nullptr, mod + 5120, (const bf16_t*)(ws + WS_X1B), 0};
        pg8::gemm_phase(lds, g, S, E);
    PROBE_T1(14) } SEAM(14);
    if (IN(15)) { PROBE_T0(15) phase_norm<1, true>(nullptr, (const bf16_t*)(ws + WS_H), p.in[I_FG], nullptr, 0, 0, nullptr, p.out); PROBE_T1(15) }
#undef IN
#undef SEAM
}

extern "C" void kernel_launch(void* const* d_in, const int* in_sizes, int n_in, void* d_out, int out_size, void* d_ws, size_t ws_size, hipStream_t stream) {
    static int grid = 0;
    if (grid == 0) {
        if (n_in != 25 || out_size != T * DM || ws_size < WS_END) { fprintf(stderr, "kernel_launch: unexpected shapes (n_in %d out %d ws %zu)\n", n_in, out_size, ws_size); grid = -1; return; }
        int dev = 0, cus = 0, per_cu = 0;
        hipGetDevice(&dev);
        hipDeviceGetAttribute(&cus, hipDeviceAttributeMultiprocessorCount, dev);
        if (hipFuncSetAttribute((const void*)fwd_kernel, hipFuncAttributeMaxDynamicSharedMemorySize, LDS_BYTES) != hipSuccess) { fprintf(stderr, "kernel_launch: hipFuncSetAttribute failed\n"); grid = -1; return; }
        if (hipOccupancyMaxActiveBlocksPerMultiprocessor(&per_cu, (const void*)fwd_kernel, NTHREADS, LDS_BYTES) != hipSuccess || per_cu < 1) { fprintf(stderr, "kernel_launch: occupancy query failed (%d)\n", per_cu); (void)hipGetLastError(); per_cu = 1; }
        grid = cus * (per_cu > 1 ? 1 : per_cu);
        if (grid < 64) { fprintf(stderr, "kernel_launch: grid %d < 64 not supported\n", grid); grid = -1; return; }
        fprintf(stderr, "kernel_launch: grid %d (cus %d, per_cu %d)\n", grid, cus, per_cu);
    }
    if (grid < 0) return;
    Params p{};
    for (int i = 0; i < 25; ++i) p.in[i] = (const float*)d_in[i];
    p.out = (float*)d_out; p.ws = (unsigned char*)d_ws;
#if N_LAUNCH_MODE == 0
    if (hipMemsetAsync((char*)d_ws + WS_CTL, 0, CTL_BYTES, stream) != hipSuccess) { fprintf(stderr, "kernel_launch: memset failed\n"); return; }
    p.ph_lo = 0; p.ph_hi = NPHASE;
    void* args[] = {&p};
    hipError_t e = hipLaunchCooperativeKernel((const void*)fwd_kernel, dim3(grid), dim3(NTHREADS), args, LDS_BYTES, stream);
    if (e != hipSuccess) fprintf(stderr, "cooperative launch failed: %s (grid %d)\n", hipGetErrorString(e), grid);
#else
    for (int ph = 0; ph < NPHASE; ++ph) {
        if (ph == 8) continue;
        p.ph_lo = ph; p.ph_hi = (ph == 7) ? 9 : ph + 1;
        hipLaunchKernelGGL(fwd_kernel, dim3(grid), dim3(NTHREADS), LDS_BYTES, stream, p);
    }
#endif
}
```

```cpp
#include <hip/hip_runtime.h>
#include <hip/hip_cooperative_groups.h>
#include <cstdio>
#include <cstdint>
namespace cg = cooperative_groups;

#ifndef N_LAUNCH_MODE
#define N_LAUNCH_MODE 0
#endif

#ifndef PROBE_SUB
#define PROBE_SUB 0
#endif
#define PSUB_T0(k) unsigned long long _st0 = 0; if (PROBE_SUB == (k)) _st0 = __builtin_amdgcn_s_memrealtime();
#define PSUB_T1(k) if (PROBE_SUB == (k)) _sacc += __builtin_amdgcn_s_memrealtime() - _st0;
#define PSUB_SPIN() if (PROBE_SUB != 0) { __syncthreads(); const unsigned long long _end = __builtin_amdgcn_s_memrealtime() + 3 * _sacc; while (__builtin_amdgcn_s_memrealtime() < _end) __builtin_amdgcn_s_sleep(16); }
#define LAS __attribute__((address_space(3)))
typedef unsigned short bf16_t;
typedef short bf16x8 __attribute__((ext_vector_type(8)));
typedef float f32x4 __attribute__((ext_vector_type(4)));
typedef float f32x2 __attribute__((ext_vector_type(2)));
typedef float f32x16 __attribute__((ext_vector_type(16)));
typedef unsigned u32x4 __attribute__((ext_vector_type(4)));
typedef unsigned u32x2 __attribute__((ext_vector_type(2)));

constexpr int NB = 8, SEQ = 4096, DM = 1024, T = NB * SEQ, NH = 8, HD = 64, RW = 512, DFF = 4096, NMOD = 6144;
constexpr int N_IN = 5384, NPROJ = 5632;
constexpr int C_R = 0, C_K = 512, C_V = 1024, C_WD = 1536, C_AD = 1600, C_GD = 1664, C_FQ = 1792, C_FK = 2304, C_FV = 2816, C_GA = 3328, C_GB = 4352, C_FL = 5376;
constexpr float NORM_EPS = 1e-6f, GN_EPS = 64e-5f, LOG2E = 1.4426950408889634f;
constexpr int NWAVES = 8, NTHREADS = 512, LDS_BYTES = 135168;
constexpr int NPHASE = 16;

constexpr size_t MiB = 1u << 20;
constexpr size_t WS_WIN = 0, WS_WOA = 11 * MiB, WS_WOB = 12 * MiB, WS_WOUT = 13 * MiB, WS_WFF1 = 15 * MiB, WS_WFF2 = 23 * MiB;
constexpr size_t WS_MOD = 31 * MiB, WS_CUM = 32 * MiB, WS_WLR = 33 * MiB;
constexpr size_t WS_CTL = 34 * MiB, CTL_BYTES = 16384;
constexpr size_t WS_LR = 484 * MiB;
constexpr size_t WS_AI = 36 * MiB;
constexpr size_t WS_H = 36 * MiB;
constexpr size_t WS_B = 36 * MiB, WS_W16 = 68 * MiB;
constexpr size_t WS_PROJ = 100 * MiB;
constexpr size_t WS_X1B = 356 * MiB;
constexpr size_t WS_G = 452 * MiB;
constexpr size_t WS_BON = 500 * MiB, WS_DC = 501 * MiB;
constexpr size_t WS_END = 502 * MiB;

__device__ __forceinline__ unsigned f2bf(float f) { unsigned u = __builtin_bit_cast(unsigned, f); return (u + 0x7fffu + ((u >> 16) & 1u)) >> 16; }
__device__ __forceinline__ unsigned pk2(float lo, float hi) { typedef __bf16 bf2_t __attribute__((ext_vector_type(2))); const f32x2 v = {lo, hi}; return __builtin_bit_cast(unsigned, __builtin_convertvector(v, bf2_t)); }
__device__ __forceinline__ float bf2f(bf16_t h) { return __builtin_bit_cast(float, (unsigned)h << 16); }
__device__ __forceinline__ float bflo(unsigned w) { return __builtin_bit_cast(float, w << 16); }
__device__ __forceinline__ float bfhi(unsigned w) { return __builtin_bit_cast(float, w & 0xffff0000u); }
__device__ __forceinline__ float sigmoidf_(float x) { return 1.f / (1.f + __expf(-x)); }
__device__ __forceinline__ float wave_sum(float v) {
#pragma unroll
    for (int o = 1; o < 64; o <<= 1) v += __shfl_xor(v, o);
    return v;
}
#define LDS_WAIT() asm volatile("s_waitcnt lgkmcnt(0)" ::: "memory")
#define LBAR() asm volatile("s_waitcnt lgkmcnt(0)\n\ts_barrier" ::: "memory")

__device__ __forceinline__ int win_src_col(int n) {
    if (n < 512) return n;
    if (n < 1536) return n + 64;
    if (n < 1600) return n - 1024;
    if (n < 3328) return n;
    if (n < 5376) return n + 8;
    if (n < 5384) return n - 2048;
    return -1;
}

namespace pg8 {
constexpr int BM = 256, BK = 64, HALF = 128, HTB = HALF * BK * 2, STAGE_BYTES = 8 * HTB, NXCD = 8, WGM = 8;
__host__ __device__ __forceinline__ int lds_byte(int r, int c) { const int st = (r >> 4) * 2 + (c >> 5), rr = r & 15, cc = c & 31, ob = rr * 64 + cc * 2; return st * 1024 + (ob ^ (((ob >> 9) & 1) << 5)); }
__host__ __device__ __forceinline__ void stage_rc(int b, int& R, int& C) { const int st = b / 1024, sb = b % 1024, swz = sb ^ (((sb >> 9) & 1) << 5); R = (st >> 1) * 16 + swz / 64; C = (st & 1) * 32 + (swz % 64) / 2; }
__host__ __device__ __forceinline__ int perm32(int rho) { const int n = rho >> 4, i = rho & 15; return 8 * (i >> 2) + 4 * n + (i & 3); }
struct Unit { int pm, pn; };
struct Gemm { const bf16_t* A; const bf16_t* Bt; int M, N, K, lda; };
struct StaticOrder {
    int nM, nN, nwg, G, c;
    __device__ void init(int M, int N, int G_, int c_) { nM = M / BM; nN = N / BM; nwg = nM * nN; G = G_; c = c_; }
    __device__ bool next(int i, Unit& u) const {
        const long L = (long)i * G + c; if (L >= nwg) return false;
        int wgid = (int)L; { const int q = nwg / NXCD, r = nwg % NXCD, xcd = wgid % NXCD, off = wgid / NXCD; wgid = (xcd < r ? xcd * (q + 1) : r * (q + 1) + (xcd - r) * q) + off; }
        const int nig = WGM * nN, gid = wgid / nig, fm = gid * WGM, gsz = (nM - fm) < WGM ? (nM - fm) : WGM;
        u.pm = fm + ((wgid % nig) % gsz); u.pn = (wgid % nig) / gsz; return true;
    }
};
__device__ __forceinline__ unsigned cvt_pk_bf16(float lo, float hi) { unsigned r; asm volatile("v_cvt_pk_bf16_f32 %0, %1, %2" : "=v"(r) : "v"(lo), "v"(hi)); return r; }

template <int MODE> struct Epi {
    bf16_t* O; int ldo; float* F; const float* X; const float* gate; const bf16_t* P; int gcol; bf16_t* O2; bf16_t* O3;
    __device__ __forceinline__ void operator()(const f32x4 (&acc)[2][2][4][2], const Unit& u, int wr, int wc, int fr, int fq) const {
        const int row0 = u.pm * BM + wr * 64 + fr, col0 = u.pn * BM + wc * 32 + 8 * fq;
        f32x4 gq[2][2];
        if (MODE == 4 || MODE == 7 || MODE == 8) {
#pragma unroll
            for (int bj = 0; bj < 2; ++bj) { const float* gp = gate + (size_t)(row0 / SEQ) * NMOD + col0 + bj * HALF; gq[bj][0] = *(const f32x4*)gp; gq[bj][1] = *(const f32x4*)(gp + 4); }
        }
#pragma unroll
        for (int ai = 0; ai < 2; ++ai)
#pragma unroll
          for (int mh = 0; mh < 2; ++mh) {
            u32x4 lg[2][2], lp[2][2]; f32x4 lx[2][2][2];
#pragma unroll
            for (int mi = 0; mi < 2; ++mi)
#pragma unroll
                for (int bj = 0; bj < 2; ++bj) {
                    const int row = row0 + ai * HALF + (2 * mh + mi) * 16, col = col0 + bj * HALF;
                    if (MODE == 2 || MODE == 3) lg[mi][bj] = *(const u32x4*)(P + (size_t)row * NPROJ + gcol + col);
                    if (MODE == 3) lp[mi][bj] = *(const u32x4*)(O + (size_t)row * ldo + col);
                    if (MODE == 4 || MODE == 7) { const float* xp = X + (size_t)row * DM + col; lx[mi][bj][0] = *(const f32x4*)xp; lx[mi][bj][1] = *(const f32x4*)(xp + 4); }
                    if (MODE == 8) lp[mi][bj] = *(const u32x4*)(P + (size_t)row * DM + col);
                }
#pragma unroll
            for (int mi = 0; mi < 2; ++mi) {
                const int m = 2 * mh + mi;
                const int row = row0 + ai * HALF + m * 16;
#pragma unroll
                for (int bj = 0; bj < 2; ++bj) {
                    const int col = col0 + bj * HALF;
                    f32x4 v0 = acc[ai][bj][m][0], v1 = acc[ai][bj][m][1];
                    if (MODE == 1) {
#pragma unroll
                        for (int j = 0; j < 4; ++j) { float a = fmaxf(v0[j], 0.f), b = fmaxf(v1[j], 0.f); v0[j] = a * a; v1[j] = b * b; }
                    }
                    if (MODE == 2 || MODE == 3) {
                        const u32x4 g = lg[mi][bj];
                        v0[0] *= sigmoidf_(bflo(g.x)); v0[1] *= sigmoidf_(bfhi(g.x)); v0[2] *= sigmoidf_(bflo(g.y)); v0[3] *= sigmoidf_(bfhi(g.y));
                        v1[0] *= sigmoidf_(bflo(g.z)); v1[1] *= sigmoidf_(bfhi(g.z)); v1[2] *= sigmoidf_(bflo(g.w)); v1[3] *= sigmoidf_(bfhi(g.w));
                    }
                    if (MODE == 3) {
                        const u32x4 pp = lp[mi][bj];
                        v0[0] += bflo(pp.x); v0[1] += bfhi(pp.x); v0[2] += bflo(pp.y); v0[3] += bfhi(pp.y);
                        v1[0] += bflo(pp.z); v1[1] += bfhi(pp.z); v1[2] += bflo(pp.w); v1[3] += bfhi(pp.w);
                    }
                    if (MODE == 4 || MODE == 7) { v0 = lx[mi][bj][0] + gq[bj][0] * v0; v1 = lx[mi][bj][1] + gq[bj][1] * v1; }
                    if (MODE == 8) {
                        const u32x4 xb = lp[mi][bj];
                        const f32x4 x0 = {bflo(xb.x), bfhi(xb.x), bflo(xb.y), bfhi(xb.y)}, x1 = {bflo(xb.z), bfhi(xb.z), bflo(xb.w), bfhi(xb.w)};
                        v0 = x0 + gq[bj][0] * v0; v1 = x1 + gq[bj][1] * v1;
                    }
                    if (MODE == 5) {
                        const int seg = u.pn >> 1, c = col - seg * RW;
                        if (seg == 0) {
                            const f32x4 b0 = *(const f32x4*)(X + c), b1 = *(const f32x4*)(X + c + 4);
                            typedef _Float16 h8 __attribute__((ext_vector_type(8))); h8 hv;
#pragma unroll
                            for (int j = 0; j < 4; ++j) { hv[j] = (_Float16)(0.6065306597f * sigmoidf_(b0[j] + v0[j])); hv[4 + j] = (_Float16)(0.6065306597f * sigmoidf_(b1[j] + v1[j])); }
                            *(h8*)((_Float16*)O2 + (size_t)row * RW + c) = hv;
                        } else if (seg == 1) {
                            const f32x4 b0 = *(const f32x4*)(gate + c), b1 = *(const f32x4*)(gate + c + 4);
#pragma unroll
                            for (int j = 0; j < 4; ++j) { v0[j] = sigmoidf_(b0[j] + v0[j]); v1[j] = sigmoidf_(b1[j] + v1[j]); }
                            u32x4 w; w.x = cvt_pk_bf16(v0[0], v0[1]); w.y = cvt_pk_bf16(v0[2], v0[3]); w.z = cvt_pk_bf16(v1[0], v1[1]); w.w = cvt_pk_bf16(v1[2], v1[3]);
                            *(u32x4*)(O + (size_t)row * RW + c) = w;
                        } else {
                            u32x4 w; w.x = cvt_pk_bf16(v0[0], v0[1]); w.y = cvt_pk_bf16(v0[2], v0[3]); w.z = cvt_pk_bf16(v1[0], v1[1]); w.w = cvt_pk_bf16(v1[2], v1[3]);
                            *(u32x4*)(O3 + (size_t)row * RW + c) = w;
                        }
                    } else if (MODE == 0 || MODE == 1 || MODE == 2 || MODE == 3 || MODE == 7 || MODE == 8) {
                        u32x4 w; w.x = cvt_pk_bf16(v0[0], v0[1]); w.y = cvt_pk_bf16(v0[2], v0[3]); w.z = cvt_pk_bf16(v1[0], v1[1]); w.w = cvt_pk_bf16(v1[2], v1[3]);
                        *(u32x4*)(O + (size_t)row * ldo + col) = w;
                    } else {
                        float* fp = F + (size_t)row * DM + col;
                        *(f32x4*)fp = v0; *(f32x4*)(fp + 4) = v1;
                    }
                }
            }
          }
    }
};

template <class EpiT>
__device__ __forceinline__ void gemm_phase(LAS unsigned char* lds, const Gemm g, const StaticOrder& S, const EpiT& E) {
    const int tid = threadIdx.x, wid = __builtin_amdgcn_readfirstlane(tid >> 6), lane = tid & 63, wr = wid >> 2, wc = wid & 3, fr = lane & 15, fq = lane >> 4;
    const int K = g.K, nt = K / BK, lda = g.lda;
    unsigned voffA[2], voffB[2];
#pragma unroll
    for (int i = 0; i < 2; ++i) { int R, C; stage_rc(tid * 16 + i * 8192, R, C); const int Rb = (R & ~31) + perm32(R & 31);
        voffA[i] = (unsigned)(R * lda + C) * 2u; voffB[i] = (unsigned)(Rb * K + C) * 2u; }
    const size_t kstep = (size_t)(BK * 2);
    const size_t hstepA = (size_t)HALF * lda * 2, hstepB = (size_t)HALF * K * 2;
    const size_t tstepA = 2 * hstepA, tstepB = 2 * hstepB;
    const unsigned ldsw = (unsigned)wid * 1024u;
    const int aoff = lds_byte(wr * 64 + fr, fq * 8), boff = lds_byte(wc * 32 + fr, fq * 8);
#define PG8_SA(b, h) (((b) * 2 + (h)) * HTB)
#define PG8_SB(b, h) ((4 + (b) * 2 + (h)) * HTB)
#define PG8_STAGE(bufoff, gbase, voff) do { _Pragma("unroll") for (int _i = 0; _i < 2; ++_i) \
        __builtin_amdgcn_global_load_lds((const unsigned*)((const char*)(gbase) + (voff)[_i]), (LAS unsigned*)(lds + (bufoff) + ldsw + _i * 8192), 16, 0, 0); } while (0)
#define PG8_LDA(dst, b, h) do { _Pragma("unroll") for (int m = 0; m < 4; ++m) _Pragma("unroll") for (int k = 0; k < 2; ++k) dst[m][k] = *(const LAS bf16x8*)(lds + PG8_SA(b, h) + aoff + m * 2048 + k * 1024); } while (0)
#define PG8_LDB(dst, b, h) do { _Pragma("unroll") for (int n = 0; n < 2; ++n) _Pragma("unroll") for (int k = 0; k < 2; ++k) dst[n][k] = *(const LAS bf16x8*)(lds + PG8_SB(b, h) + boff + n * 2048 + k * 1024); } while (0)
#define PG8_MMA(ai, bj, At, Bt) do { __builtin_amdgcn_s_setprio(1); _Pragma("unroll") for (int m = 0; m < 4; ++m) _Pragma("unroll") for (int n = 0; n < 2; ++n) _Pragma("unroll") for (int k = 0; k < 2; ++k) \
        acc[ai][bj][m][n] = __builtin_amdgcn_mfma_f32_16x16x32_bf16(Bt[n][k], At[m][k], acc[ai][bj][m][n], 0, 0, 0); __builtin_amdgcn_s_setprio(0); } while (0)
#define PG8_WAIT_V(n) asm volatile("s_waitcnt vmcnt(" #n ")" ::: "memory")
#define PG8_WAIT_L(n) asm volatile("s_waitcnt lgkmcnt(" #n ")" ::: "memory")
#define PG8_BAR __builtin_amdgcn_s_barrier()
#define PG8_SCHED __builtin_amdgcn_sched_barrier(0)
    Unit cur, nxt; int ui = 0;
    if (!S.next(0, cur)) return;
    f32x4 acc[2][2][4][2];
#pragma unroll
    for (int a = 0; a < 2; ++a)
#pragma unroll
        for (int b = 0; b < 2; ++b)
#pragma unroll
            for (int m = 0; m < 4; ++m)
#pragma unroll
                for (int n = 0; n < 2; ++n) acc[a][b][m][n] = (f32x4){0.f, 0.f, 0.f, 0.f};
    bf16x8 At[4][2], B0[2][2], B1[2][2];
    const char* cA = (const char*)g.A + (size_t)cur.pm * tstepA; const char* cB = (const char*)g.Bt + (size_t)cur.pn * tstepB;
    PG8_STAGE(PG8_SB(0, 0), cB, voffB); PG8_STAGE(PG8_SB(0, 1), cB + hstepB, voffB); PG8_STAGE(PG8_SA(0, 0), cA, voffA); PG8_STAGE(PG8_SA(0, 1), cA + hstepA, voffA);
    if (wr == 1) PG8_BAR;
    PG8_WAIT_V(2); PG8_BAR;
    PG8_STAGE(PG8_SB(1, 0), cB + kstep, voffB); PG8_STAGE(PG8_SA(1, 0), cA + kstep, voffA); PG8_STAGE(PG8_SB(1, 1), cB + hstepB + kstep, voffB);
    PG8_WAIT_V(6); PG8_BAR;
    for (;;) {
        const bool has_next = S.next(ui + 1, nxt);
        const char* nA = has_next ? (const char*)g.A + (size_t)nxt.pm * tstepA : cA; const char* nB = has_next ? (const char*)g.Bt + (size_t)nxt.pn * tstepB : cB;
        for (int t = 0; t < nt; t += 2) {
            const bool last = (t == nt - 2);
            const char* a1 = cA + (size_t)(t + 1) * kstep;
            const char* a2 = last ? nA : cA + (size_t)(t + 2) * kstep; const char* b2 = last ? nB : cB + (size_t)(t + 2) * kstep;
            const char* a3 = a2 + kstep; const char* b3 = b2 + kstep;
            PG8_LDB(B0, 0, 0); PG8_LDB(B1, 0, 1); PG8_SCHED; PG8_LDA(At, 0, 0); PG8_STAGE(PG8_SA(1, 1), a1 + hstepA, voffA);
            PG8_WAIT_V(8); PG8_WAIT_L(0); PG8_BAR; PG8_MMA(0, 0, At, B0); PG8_MMA(0, 1, At, B1); PG8_BAR; PG8_SCHED;
            PG8_LDA(At, 0, 1); PG8_STAGE(PG8_SB(0, 0), b2, voffB); PG8_STAGE(PG8_SB(0, 1), b2 + hstepB, voffB); PG8_STAGE(PG8_SA(0, 0), a2, voffA);
            PG8_WAIT_V(8); PG8_WAIT_L(0); PG8_BAR; PG8_MMA(1, 0, At, B0); PG8_MMA(1, 1, At, B1); PG8_BAR; PG8_SCHED;
            PG8_LDB(B0, 1, 0); PG8_LDB(B1, 1, 1); PG8_SCHED; PG8_LDA(At, 1, 0); PG8_STAGE(PG8_SA(0, 1), a2 + hstepA, voffA);
            PG8_WAIT_V(8); PG8_WAIT_L(0); PG8_BAR; PG8_MMA(0, 0, At, B0); PG8_MMA(0, 1, At, B1); PG8_BAR; PG8_SCHED;
            PG8_LDA(At, 1, 1); PG8_STAGE(PG8_SB(1, 0), b3, voffB); PG8_STAGE(PG8_SB(1, 1), b3 + hstepB, voffB); PG8_STAGE(PG8_SA(1, 0), a3, voffA);
            PG8_WAIT_V(8); PG8_WAIT_L(0); PG8_BAR; PG8_MMA(1, 0, At, B0); PG8_MMA(1, 1, At, B1); PG8_BAR; PG8_SCHED;
        }
        if (wr == 0) PG8_BAR;
        E(acc, cur, wr, wc, fr, fq);
        if (!has_next) break;
#pragma unroll
        for (int a = 0; a < 2; ++a)
#pragma unroll
            for (int b = 0; b < 2; ++b)
#pragma unroll
                for (int m = 0; m < 4; ++m)
#pragma unroll
                    for (int n = 0; n < 2; ++n) acc[a][b][m][n] = (f32x4){0.f, 0.f, 0.f, 0.f};
        cur = nxt; cA = nA; cB = nB; ++ui;
        if (wr == 1) PG8_BAR;
    }
    PG8_WAIT_V(0);
    PG8_BAR;
#undef PG8_SA
#undef PG8_SB
#undef PG8_STAGE
#undef PG8_LDA
#undef PG8_LDB
#undef PG8_MMA
#undef PG8_WAIT_V
#undef PG8_WAIT_L
#undef PG8_BAR
#undef PG8_SCHED
}
}

struct Params { const float* in[25]; float* out; unsigned char* ws; int ph_lo, ph_hi; };
enum { I_X = 0, I_C, I_WADA, I_BADA, I_N1G, I_WIN, I_MU, I_WDU, I_DBASE, I_WIU, I_IBASE, I_WGU, I_KKS, I_KMIX, I_RBON, I_LNW, I_LNB, I_FBIAS, I_WOA, I_WOB, I_WOUT, I_N2G, I_WFF1, I_WFF2, I_FG };

__device__ __forceinline__ void transpose_item(const float* __restrict__ W, int K, int Nsrc, int nblk, bf16_t* WT, LAS float* scr, int item, int lane, bool map) {
    const int kb = item / nblk, nb = item % nblk, k0 = 64 * kb, n0 = 32 * nb;
    const int n = n0 + (lane & 31); const int sc = map ? win_src_col(n) : n;
    float tv[32];
#pragma unroll
    for (int i = 0; i < 32; ++i) { const int kk = 2 * i + (lane >> 5); tv[i] = (sc >= 0) ? W[(size_t)(k0 + kk) * Nsrc + sc] : 0.f; }
#pragma unroll
    for (int i = 0; i < 32; ++i) { const int kk = 2 * i + (lane >> 5); scr[kk * 33 + (lane & 31)] = tv[i]; }
    LDS_WAIT();
    const int c = lane & 7;
#pragma unroll
    for (int j = 0; j < 4; ++j) { const int nn = (lane >> 3) + 8 * j; const LAS float* s = scr + (8 * c) * 33 + nn;
        u32x4 o; o.x = pk2(s[0 * 33], s[1 * 33]); o.y = pk2(s[2 * 33], s[3 * 33]); o.z = pk2(s[4 * 33], s[5 * 33]); o.w = pk2(s[6 * 33], s[7 * 33]);
        *(u32x4*)(WT + (size_t)(n0 + nn) * K + k0 + 8 * c) = o; }
    LDS_WAIT();
}

__device__ __forceinline__ void phase_p0(const Params& p, LAS unsigned char* lds) {
    const int tid = threadIdx.x, lane = tid & 63, wave = tid >> 6;
    const int gw = blockIdx.x * NWAVES + wave, NGW = gridDim.x * NWAVES;
    LAS float* scr = (LAS float*)(lds + wave * 8448);
    LAS float* cact = (LAS float*)(lds + 73728);
    for (int i = tid; i < NB * DM; i += NTHREADS) { const int b = i >> 10, k = i & 1023; const float c = p.in[I_C][i]; cact[k * 8 + b] = c / (1.f + __expf(-c)); }
    __syncthreads();
    unsigned char* ws = p.ws;
    {   bf16_t* WLR = (bf16_t*)(ws + WS_WLR);
        for (int i = blockIdx.x * NTHREADS + tid; i < 1536 * 256; i += gridDim.x * NTHREADS) {
            const int n = i >> 8, k = i & 255; float v = 0.f;
            if (n < 512) { if (k < 64) v = p.in[I_WDU][k * RW + n]; }
            else if (n < 1024) { if (k >= 64 && k < 128) v = p.in[I_WIU][(k - 64) * RW + (n - 512)]; }
            else { if (k >= 128) v = p.in[I_WGU][(k - 128) * RW + (n - 1024)]; }
            WLR[i] = (bf16_t)f2bf(v);
        } }
    constexpr int I_1 = 16 * 176, I_2 = 8 * 32, I_3 = 8 * 32, I_4 = 16 * 32, I_5 = 16 * 128, I_6 = 64 * 32, I_7 = NMOD / 32;
    constexpr int NITEMS = I_1 + I_2 + I_3 + I_4 + I_5 + I_6;
    for (int cb = blockIdx.x; cb < I_7; cb += gridDim.x) {
        LAS float* red = (LAS float*)(lds + 106496);
        const int col = 32 * cb + (lane & 31), kh = lane >> 5, kbase = 128 * wave + 64 * kh;
        float acc[8];
#pragma unroll
        for (int b = 0; b < 8; ++b) acc[b] = 0.f;
        const float* wp = p.in[I_WADA] + (size_t)kbase * NMOD + col;
#pragma unroll 16
        for (int i = 0; i < 64; ++i) {
            const float wv = wp[(size_t)i * NMOD];
            const f32x4 c0 = *(const LAS f32x4*)(cact + (kbase + i) * 8), c1 = *(const LAS f32x4*)(cact + (kbase + i) * 8 + 4);
            acc[0] += c0[0] * wv; acc[1] += c0[1] * wv; acc[2] += c0[2] * wv; acc[3] += c0[3] * wv;
            acc[4] += c1[0] * wv; acc[5] += c1[1] * wv; acc[6] += c1[2] * wv; acc[7] += c1[3] * wv;
        }
#pragma unroll
        for (int b = 0; b < 8; ++b) { const float sv = acc[b] + __shfl_xor(acc[b], 32); if (kh == 0) red[(wave * 8 + b) * 32 + (lane & 31)] = sv; }
        __syncthreads();
        if (tid < 256) { const int b = tid >> 5, c = tid & 31; float sv = 0.f;
#pragma unroll
            for (int w = 0; w < 8; ++w) sv += red[(w * 8 + b) * 32 + c];
            ((float*)(ws + WS_MOD))[b * NMOD + 32 * cb + c] = sv + p.in[I_BADA][32 * cb + c]; }
        __syncthreads();
    }
    for (int it = gw; it < NITEMS; it += NGW) {
        int r = it;
        if (r < I_1) { transpose_item(p.in[I_WIN], DM, N_IN, NPROJ / 32, (bf16_t*)(ws + WS_WIN), scr, r, lane, true); continue; } r -= I_1;
        if (r < I_2) { transpose_item(p.in[I_WOA], RW, DM, DM / 32, (bf16_t*)(ws + WS_WOA), scr, r, lane, false); continue; } r -= I_2;
        if (r < I_3) { transpose_item(p.in[I_WOB], RW, DM, DM / 32, (bf16_t*)(ws + WS_WOB), scr, r, lane, false); continue; } r -= I_3;
        if (r < I_4) { transpose_item(p.in[I_WOUT], DM, DM, DM / 32, (bf16_t*)(ws + WS_WOUT), scr, r, lane, false); continue; } r -= I_4;
        if (r < I_5) { transpose_item(p.in[I_WFF1], DM, DFF, DFF / 32, (bf16_t*)(ws + WS_WFF1), scr, r, lane, false); continue; } r -= I_5;
        transpose_item(p.in[I_WFF2], DFF, DM, DM / 32, (bf16_t*)(ws + WS_WFF2), scr, r, lane, false);
    }
}

template <int MODE, bool INB>
__device__ __forceinline__ void phase_norm(const float* X, const bf16_t* Xb, const float* g, const float* mod, int shoff, int scoff, bf16_t* Hout, float* Fout) {
    constexpr int R = 4;
    const int tid = threadIdx.x, lane = tid & 63, wave = tid >> 6;
    const int gw = blockIdx.x * NWAVES + wave, NGW = gridDim.x * NWAVES;
    f32x4 g4[4];
#pragma unroll
    for (int j = 0; j < 4; ++j) g4[j] = *(const f32x4*)(g + 4 * lane + 256 * j);
    for (int m0 = gw; m0 < T; m0 += R * NGW) {
        f32x4 v[R][4];
#pragma unroll
        for (int r = 0; r < R; ++r) {
            const int m = m0 + r * NGW; const int mm = (m < T) ? m : m0;
            if (INB) {
                const u32x2* xr = (const u32x2*)(Xb + (size_t)mm * DM) + lane;
#pragma unroll
                for (int j = 0; j < 4; ++j) { const u32x2 w = xr[64 * j]; v[r][j] = (f32x4){bflo(w.x), bfhi(w.x), bflo(w.y), bfhi(w.y)}; }
            } else {
                const f32x4* xr = (const f32x4*)(X + (size_t)mm * DM) + lane;
#pragma unroll
                for (int j = 0; j < 4; ++j) v[r][j] = xr[64 * j];
            }
        }
        float s[R];
#pragma unroll
        for (int r = 0; r < R; ++r) { s[r] = 0.f;
#pragma unroll
            for (int j = 0; j < 4; ++j) s[r] += (v[r][j].x * v[r][j].x + v[r][j].y * v[r][j].y) + (v[r][j].z * v[r][j].z + v[r][j].w * v[r][j].w); }
#pragma unroll
        for (int o = 1; o < 64; o <<= 1) {
#pragma unroll
            for (int r = 0; r < R; ++r) s[r] += __shfl_xor(s[r], o);
        }
#pragma unroll
        for (int r = 0; r < R; ++r) {
            const int m = m0 + r * NGW; if (m >= T) break;
            const float rstd = rsqrtf(s[r] * (1.f / DM) + NORM_EPS);
            const int b = m / SEQ;
#pragma unroll
            for (int j = 0; j < 4; ++j) {
                const int col = 4 * lane + 256 * j;
                f32x4 y = v[r][j] * rstd * g4[j];
                if (MODE == 0) {
                    const f32x4 sc = *(const f32x4*)(mod + (size_t)b * NMOD + scoff + col), sh = *(const f32x4*)(mod + (size_t)b * NMOD + shoff + col);
                    y = y * (sc + 1.f) + sh;
                    u32x2 o; o.x = pk2(y.x, y.y); o.y = pk2(y.z, y.w);
                    *(u32x2*)(Hout + (size_t)m * DM + col) = o;
                } else {
                    *(f32x4*)(Fout + (size_t)m * DM + col) = y;
                }
            }
        }
    }
}

__device__ __forceinline__ float logsigmoidf_(float x) { return fminf(x, 0.f) - log1pf(__expf(-fabsf(x))); }
__device__ __forceinline__ void unpack8(const u32x4 v, float* f) { f[0] = bflo(v.x); f[1] = bfhi(v.x); f[2] = bflo(v.y); f[3] = bfhi(v.y); f[4] = bflo(v.z); f[5] = bfhi(v.z); f[6] = bflo(v.w); f[7] = bfhi(v.w); }
__device__ __forceinline__ u32x4 pack8(const float* f) { u32x4 w; w.x = pk2(f[0], f[1]); w.y = pk2(f[2], f[3]); w.z = pk2(f[4], f[5]); w.w = pk2(f[6], f[7]); return w; }
__device__ __forceinline__ float sum8(float v) { v += __shfl_xor(v, 1); v += __shfl_xor(v, 2); v += __shfl_xor(v, 4); return v; }

__device__ __forceinline__ void phase_lrin(const Params& p, LAS unsigned char* lds) {
    const int gt = blockIdx.x * NTHREADS + threadIdx.x, NT = gridDim.x * NTHREADS;
    const bf16_t* PROJ = (const bf16_t*)(p.ws + WS_PROJ); bf16_t* LR = (bf16_t*)(p.ws + WS_LR);
    for (int idx = gt; idx < T * 32; idx += NT) {
        const int t = idx >> 5, g = idx & 31, col = C_WD + g * 8;
        const float* mup = p.in[I_MU] + win_src_col(col);
        const f32x4 m0 = *(const f32x4*)mup, m1 = *(const f32x4*)(mup + 4);
        const float mu[8] = {m0[0], m0[1], m0[2], m0[3], m1[0], m1[1], m1[2], m1[3]};
        float c[8], q[8];
        unpack8(*(const u32x4*)(PROJ + (size_t)t * NPROJ + col), c);
        if (t % SEQ == 0) {
#pragma unroll
            for (int j = 0; j < 8; ++j) q[j] = 0.f;
        } else unpack8(*(const u32x4*)(PROJ + (size_t)(t - 1) * NPROJ + col), q);
#pragma unroll
        for (int j = 0; j < 8; ++j) { const float v = c[j] + mu[j] * (q[j] - c[j]); c[j] = (g < 8) ? (1.f - 2.f / (1.f + __expf(2.f * v))) : ((g < 16) ? v : sigmoidf_(v)); }
        *(u32x4*)(LR + (size_t)t * 256 + g * 8) = pack8(c);
    }
    {   const int tid = threadIdx.x, lane = tid & 63, wave = tid >> 6;
        float* CUM = (float*)(p.ws + WS_CUM); LAS float* wtot = (LAS float*)lds;
        for (int bh = blockIdx.x; bh < NB * NH; bh += gridDim.x) {
            const int b = bh >> 3, h = bh & 7; const float fb = p.in[I_FBIAS][h];
            const int s0 = wave * 512 + lane * 8;
            const bf16_t* src = PROJ + (size_t)(b * SEQ + s0) * NPROJ + C_FL + h;
            float v[8];
#pragma unroll
            for (int i = 0; i < 8; ++i) v[i] = bf2f(src[(size_t)i * NPROJ]);
            float run = 0.f;
#pragma unroll
            for (int i = 0; i < 8; ++i) { run += logsigmoidf_(v[i] + fb); v[i] = run; }
            float inc = run;
#pragma unroll
            for (int o = 1; o < 64; o <<= 1) { const float n = __shfl_up(inc, o); if (lane >= o) inc += n; }
            if (lane == 63) wtot[wave] = inc;
            __syncthreads();
            float off = inc - run;
#pragma unroll
            for (int w2 = 0; w2 < 8; ++w2) off += (w2 < wave) ? wtot[w2] : 0.f;
            float* dst = CUM + (size_t)bh * SEQ + s0;
            *(f32x4*)dst = (f32x4){off + v[0], off + v[1], off + v[2], off + v[3]}; *(f32x4*)(dst + 4) = (f32x4){off + v[4], off + v[5], off + v[6], off + v[7]};
            __syncthreads();
        }
    }
}

__device__ __forceinline__ void phase_rkvab(const Params& p) {
    const int tid = threadIdx.x, lane = tid & 63, wave = tid >> 6;
    const int gt = blockIdx.x * NTHREADS + tid, NT = gridDim.x * NTHREADS;
    unsigned char* ws = p.ws;
    const bf16_t* PROJ = (const bf16_t*)(ws + WS_PROJ);
    bf16_t* Rb = (bf16_t*)p.out; bf16_t* Kb = Rb + (size_t)T * RW; bf16_t* Vb = Kb + (size_t)T * RW; bf16_t* Ab = Vb + (size_t)T * RW;
    bf16_t* Bb = (bf16_t*)(ws + WS_B);
    const int c = (gt & 63) * 8;
    float mur[8], muk[8], muv[8], kks[8], mix[8], rbn[8];
    float* BON = (float*)(ws + WS_BON);
#pragma unroll
    for (int j = 0; j < 8; ++j) { rbn[j] = p.in[I_RBON][c + j]; mur[j] = p.in[I_MU][c + j]; muk[j] = p.in[I_MU][576 + c + j]; muv[j] = p.in[I_MU][1088 + c + j]; kks[j] = p.in[I_KKS][c + j]; mix[j] = p.in[I_KMIX][c + j]; }
    for (int idx = gt; idx < T * 64; idx += NT) {
        const int t = idx >> 6; const bool first = (t % SEQ == 0);
        const bf16_t* row = PROJ + (size_t)t * NPROJ + c; const bf16_t* prow = row - NPROJ;
        float r[8], k[8], v[8], a[8], q[8];
        unpack8(*(const u32x4*)(row + C_R), r); unpack8(*(const u32x4*)(row + C_K), k); unpack8(*(const u32x4*)(row + C_V), v);
        const size_t o = (size_t)t * RW + c;
        unpack8(*(const u32x4*)(Bb + o), a);
        if (!first) {
            unpack8(*(const u32x4*)(prow + C_R), q);
#pragma unroll
            for (int j = 0; j < 8; ++j) r[j] += mur[j] * (q[j] - r[j]);
            unpack8(*(const u32x4*)(prow + C_K), q);
#pragma unroll
            for (int j = 0; j < 8; ++j) k[j] += muk[j] * (q[j] - k[j]);
            unpack8(*(const u32x4*)(prow + C_V), q);
#pragma unroll
            for (int j = 0; j < 8; ++j) v[j] += muv[j] * (q[j] - v[j]);
        } else {
#pragma unroll
            for (int j = 0; j < 8; ++j) { r[j] -= mur[j] * r[j]; k[j] -= muk[j] * k[j]; v[j] -= muv[j] * v[j]; }
        }
        float kk[8], ss = 0.f;
#pragma unroll
        for (int j = 0; j < 8; ++j) { kk[j] = k[j] * kks[j]; ss += kk[j] * kk[j]; }
        ss = sum8(ss);
        const float inv = 1.f / fmaxf(sqrtf(ss), 1e-12f);
        float av[8], bv[8], kp[8];
#pragma unroll
        for (int j = 0; j < 8; ++j) { kk[j] *= inv; av[j] = -kk[j]; bv[j] = kk[j] * a[j]; kp[j] = k[j] * (1.f + (a[j] - 1.f) * mix[j]); }
        float bs = 0.f;
#pragma unroll
        for (int j = 0; j < 8; ++j) bs += r[j] * kp[j] * rbn[j];
        bs = sum8(bs);
        if ((lane & 7) == 0) BON[(size_t)t * NH + (c >> 6)] = bs;
        *(u32x4*)(Rb + o) = pack8(r); *(u32x4*)(Kb + o) = pack8(kp); *(u32x4*)(Vb + o) = pack8(v); *(u32x4*)(Ab + o) = pack8(av); *(u32x4*)(Bb + o) = pack8(bv);
    }
}

typedef float f32x4_t __attribute__((ext_vector_type(4)));
__device__ __forceinline__ f32x4 mfma16(const u32x4 a, const u32x4 b, const f32x4 c) { return __builtin_amdgcn_mfma_f32_16x16x32_bf16(__builtin_bit_cast(bf16x8, a), __builtin_bit_cast(bf16x8, b), c, 0, 0, 0); }

__host__ __device__ constexpr int tri_off(int i) { return (i == 0) ? 0 : 4 * (2 * ((i - 1) >> 2) * (((i - 1) >> 2) + 1) + ((i - 1) - 4 * ((i - 1) >> 2)) * (((i - 1) >> 2) + 1)); }
static_assert(tri_off(1) == 0 && tri_off(2) == 4 && tri_off(5) == 16 && tri_off(6) == 24 && tri_off(64) == 2112, "tri_off");
__device__ __forceinline__ void phase_x1(const Params& p, LAS unsigned char* lds) {
    const int tid = threadIdx.x, lane = tid & 63, wave = __builtin_amdgcn_readfirstlane(tid >> 6);
    unsigned char* ws = p.ws;
    bf16_t* Rb = (bf16_t*)p.out; bf16_t* Kb = Rb + (size_t)T * RW; bf16_t* Ab = Rb + (size_t)3 * T * RW;
    bf16_t* Bb = (bf16_t*)(ws + WS_B); bf16_t* Wb = (bf16_t*)(ws + WS_W16);
    bf16_t* PROJ = (bf16_t*)(ws + WS_PROJ); float* DC = (float*)(ws + WS_DC);
    LAS bf16_t* OPS = (LAS bf16_t*)lds;
    LAS bf16_t* BKT = (LAS bf16_t*)(lds + 36864);
    LAS float* TOT = (LAS float*)(lds + 55296);
    LAS float* NB = (LAS float*)(lds + 57344);
    const int t = tid >> 3, jg = tid & 7;
    typedef _Float16 h8 __attribute__((ext_vector_type(8)));
    u32x4 lu, la, lr, lb, lk;
#define X1_ITEM(n_, it_, ok_) const int it_##g = blockIdx.x + ((n_) >> 3) * gridDim.x; const bool ok_ = it_##g < 512; const int it_ = it_##g * 8 + ((n_) & 7);
#define X1_LOAD(it_) do { const int bh_ = (it_) >> 6, c_ = (it_) & 63; const size_t o_ = ((size_t)(bh_ >> 3) * SEQ + c_ * 64 + t) * RW + (bh_ & 7) * 64 + 8 * jg; \
        lu = *(const u32x4*)(Wb + o_); la = *(const u32x4*)(Ab + o_); lr = *(const u32x4*)(Rb + o_); lb = *(const u32x4*)(Bb + o_); lk = *(const u32x4*)(Kb + o_); } while (0)
    { X1_ITEM(0, it0, ok0) if (ok0) X1_LOAD(it0); }
    for (int n = 0;; ++n) {
        X1_ITEM(n, it, ok) if (!ok) break;
        const int q = n & 7, grp = it >> 3;
        const int bh = it >> 6, c = it & 63, b = bh >> 3, h = bh & 7;
        const size_t base = (size_t)b * SEQ + c * 64; const int colh = h * 64;
        {
            float u[8], cs[8], av[8], rv[8], bv[8], kv[8];
            { const h8 hv = __builtin_bit_cast(h8, lu);
#pragma unroll
              for (int e = 0; e < 8; ++e) { u[e] = (float)hv[e]; cs[e] = u[e]; } }
            unpack8(la, av); unpack8(lr, rv); unpack8(lb, bv); unpack8(lk, kv);
#pragma unroll
            for (int d = 8; d < 64; d <<= 1) {
#pragma unroll
                for (int e = 0; e < 8; ++e) { const float nv = __shfl_up(cs[e], d); if (lane >= d) cs[e] += nv; }
            }
            if (lane >= 56) { *(LAS f32x4*)(TOT + wave * 64 + 8 * jg) = (f32x4){cs[0], cs[1], cs[2], cs[3]}; *(LAS f32x4*)(TOT + wave * 64 + 8 * jg + 4) = (f32x4){cs[4], cs[5], cs[6], cs[7]}; }
            LBAR();
            { X1_ITEM(n + 1, itn, okn) if (okn) X1_LOAD(itn); }
            float off[8], tot[8];
#pragma unroll
            for (int e = 0; e < 8; ++e) { off[e] = 0.f; tot[e] = 0.f; }
#pragma unroll
            for (int w2 = 0; w2 < 8; ++w2) { const f32x4 t0 = *(const LAS f32x4*)(TOT + w2 * 64 + 8 * jg), t1 = *(const LAS f32x4*)(TOT + w2 * 64 + 8 * jg + 4);
                const float sel = (w2 < wave) ? 1.f : 0.f;
#pragma unroll
                for (int e = 0; e < 4; ++e) { tot[e] += t0[e]; tot[4 + e] += t1[e]; off[e] += sel * t0[e]; off[4 + e] += sel * t1[e]; } }
            float at[8], rt[8], bt[8], kt[8];
#pragma unroll
            for (int e = 0; e < 8; ++e) {
                const float Lc = -(off[e] + cs[e]), Lp = Lc + u[e];
                const float e1 = __expf(Lp), e2 = __expf(Lc), e3 = __expf(-Lc), e4 = __expf(-tot[e] - Lc);
                at[e] = av[e] * e1; rt[e] = rv[e] * e2; bt[e] = bv[e] * e3; kt[e] = kv[e] * e3;
                BKT[(8 * jg + e) * 72 + (t ^ (8 * jg))] = (bf16_t)f2bf(bv[e] * e4); BKT[4608 + (8 * jg + e) * 72 + (t ^ (8 * jg))] = (bf16_t)f2bf(kv[e] * e4);
            }
            const u32x4 pa = pack8(at), pr = pack8(rt);
            *(LAS u32x4*)(OPS + t * 72 + 8 * jg) = pa; *(LAS u32x4*)(OPS + 4608 + t * 72 + 8 * jg) = pr;
            *(LAS u32x4*)(OPS + 2 * 4608 + t * 72 + 8 * jg) = pack8(bt); *(LAS u32x4*)(OPS + 3 * 4608 + t * 72 + 8 * jg) = pack8(kt);
            const size_t o = (base + t) * RW + colh + 8 * jg;
            *(u32x4*)(Ab + o) = pa; *(u32x4*)(Rb + o) = pr;
            if (t == 0) { float* dp = DC + (size_t)it * 64 + 8 * jg;
                *(f32x4*)dp = (f32x4){__expf(-tot[0]), __expf(-tot[1]), __expf(-tot[2]), __expf(-tot[3])}; *(f32x4*)(dp + 4) = (f32x4){__expf(-tot[4]), __expf(-tot[5]), __expf(-tot[6]), __expf(-tot[7])}; }
        }
        LBAR();
        {
            const int jr = tid >> 3, sg = (tid & 7) * 8; const size_t o = (base + jr) * RW + colh + sg;
            *(u32x4*)(Bb + o) = *(const LAS u32x4*)(BKT + jr * 72 + (sg ^ (8 * (jr >> 3))));
            *(u32x4*)(Kb + o) = *(const LAS u32x4*)(BKT + 4608 + jr * 72 + (sg ^ (8 * (jr >> 3))));
        }
        {
            const int mm = wave >> 1, half = wave & 1, m = lane & 15, kq = lane >> 4;
            const LAS bf16_t* Srow = OPS + ((mm & 1) ? 3 * 4608 : 2 * 4608);
            const LAS bf16_t* Trow = OPS + ((mm >= 2) ? 4608 : 0);
#pragma unroll
            for (int th = 0; th < 2; ++th) {
                const int tt = (half == 0) ? (th == 0 ? 0 : 3) : (th == 0 ? 1 : 2);
                const u32x4 bf0 = *(const LAS u32x4*)(Trow + (16 * tt + m) * 72 + kq * 8), bf1 = *(const LAS u32x4*)(Trow + (16 * tt + m) * 72 + kq * 8 + 32);
                const int tq = 16 * tt + m;
#pragma unroll
                for (int ts = 0; ts < 4; ++ts) {
                    f32x4 acc = {0.f, 0.f, 0.f, 0.f};
                    if (ts <= tt) {
                        const u32x4 af0 = *(const LAS u32x4*)(Srow + (16 * ts + m) * 72 + kq * 8), af1 = *(const LAS u32x4*)(Srow + (16 * ts + m) * 72 + kq * 8 + 32);
                        acc = mfma16(af0, bf0, acc); acc = mfma16(af1, bf1, acc);
                    }
                    const int s0 = 16 * ts + 4 * kq;
                    if (mm == 0) { if (s0 < tq) *(LAS f32x4*)(NB + q * 2112 + tri_off(tq) + s0) = acc; }
                    else {
                        float v[4];
#pragma unroll
                        for (int i = 0; i < 4; ++i) { const int sx = s0 + i; const bool keep = (mm == 1) ? (sx < tq) : (sx <= tq); v[i] = keep ? acc[i] : 0.f; }
                        u32x2 o; o.x = pk2(v[0], v[1]); o.y = pk2(v[2], v[3]);
                        if (mm == 1) *(u32x2*)(Wb + (base + tq) * RW + colh + s0) = o;
                        else if (mm == 2) *(u32x2*)(PROJ + (base + tq) * NPROJ + ((h < 4) ? C_WD + colh : C_FL + colh - 256) + s0) = o;
                        else *(u32x2*)(PROJ + (base + tq) * NPROJ + C_V + colh + s0) = o;
                    }
                }
            }
        }
        LBAR();
        if (q == 7) {
            {
                const int it4 = grp * 8 + wave, bh4 = it4 >> 6, c4 = it4 & 63;
                const size_t base4 = (size_t)(bh4 >> 3) * SEQ + c4 * 64;
                const LAS float* N = NB + wave * 2112; const int cc = lane;
                bf16_t* Td = PROJ + base4 * NPROJ + C_R + (bh4 & 7) * 64 + cc;
                float Tr[64];
#pragma unroll
                for (int i = 0; i < 64; ++i) {
                    float a0 = (cc == i) ? 1.f : 0.f, a1 = 0.f;
#pragma unroll
                    for (int j4 = 0; j4 < (i + 3) / 4; ++j4) {
                        const f32x4 nv = *(const LAS f32x4*)(N + tri_off(i) + 4 * j4);
#pragma unroll
                        for (int e = 0; e < 4; ++e) { const int j = 4 * j4 + e; if (j < i) { if (e & 1) a1 += nv[e] * Tr[j]; else a0 += nv[e] * Tr[j]; } }
                    }
                    Tr[i] = a0 + a1;
                    Td[(size_t)i * NPROJ] = (bf16_t)f2bf(Tr[i]);
                }
            }
            LBAR();
        }
    }
#undef X1_ITEM
#undef X1_LOAD
}

struct SOpsA { u32x4 at[2], aak[2]; f32x4 dc; };
struct SOpsB { u32x4 f[12]; };

__device__ __forceinline__ void phase_s(const Params& p, LAS unsigned char* lds) {
    const int tid = threadIdx.x, lane = tid & 63, wave = __builtin_amdgcn_readfirstlane(tid >> 6);
    unsigned char* ws = p.ws;
    const bf16_t* Rb = (const bf16_t*)p.out; const bf16_t* Kb = Rb + (size_t)T * RW; const bf16_t* Vb = Rb + (size_t)2 * T * RW; const bf16_t* Ab = Rb + (size_t)3 * T * RW;
    const bf16_t* Bb = (const bf16_t*)(ws + WS_B); const bf16_t* Wb = (const bf16_t*)(ws + WS_W16);
    const bf16_t* PROJ = (const bf16_t*)(ws + WS_PROJ); const float* DC = (const float*)(ws + WS_DC);
    unsigned char* PROJb = ws + WS_PROJ;
    LAS bf16_t* Ht = (LAS bf16_t*)lds;
    LAS bf16_t* Xt = (LAS bf16_t*)(lds + 18432);
    LAS bf16_t* Ut = (LAS bf16_t*)(lds + 27648);
    LAS bf16_t* Vt = (LAS bf16_t*)(lds + 36864);
    LAS unsigned char* BS = lds + 55296;
    const unsigned lo1 = (unsigned)(((lane & 15) * RW + (lane >> 4) * 8) * 2), lo2 = (unsigned)(((lane & 15) * NPROJ + (lane >> 4) * 8) * 2);
    const int m = lane & 15, kq = lane >> 4, cw = wave & 3;
    if (blockIdx.x < NB * NH) {
        const int bh = blockIdx.x;
        const int b = bh >> 3, h = bh & 7, colh = h * 64, arbcol = (h < 4) ? C_WD + colh : C_FL + colh - 256;
        const size_t rowb = (size_t)b * SEQ;
        const int ps = tid >> 3, pn = (tid & 7) * 8;
#define S_VLOAD(ch, S) do { va##S = *(const u32x4*)(Vb + (rowb + (size_t)(ch) * 64 + ps) * RW + colh + pn); } while (0)
#define S_VPUT(d, w_, e) do { (d)[(e) * 72] = (bf16_t)((w_) & 0xffffu); (d)[((e) + 1) * 72] = (bf16_t)((w_) >> 16); } while (0)
#define S_VWRITE(buf, S) do { LAS bf16_t* d_ = Vt + (buf) * 4608 + pn * 72 + ps; \
            S_VPUT(d_, va##S.x, 0); S_VPUT(d_, va##S.y, 2); S_VPUT(d_, va##S.z, 4); S_VPUT(d_, va##S.w, 6); } while (0)
#define S_UB(arr, pitch, ch, col) ((const char*)((arr) + (rowb + (size_t)(ch) * 64 + 16 * cw) * (pitch) + (col)))
#define S_OLOAD_A(o, ch) do { \
            _Pragma("unroll") for (int ks = 0; ks < 2; ++ks) { \
                (o).at[ks] = *(const u32x4*)(S_UB(Ab, RW, ch, colh + 32 * ks) + lo1); (o).aak[ks] = *(const u32x4*)(S_UB(Wb, RW, ch, colh + 32 * ks) + lo1); } \
            (o).dc = *(const f32x4*)(DC + ((size_t)bh * 64 + (ch)) * 64 + 16 * cw + 4 * kq); } while (0)
#define S_OLOAD_B(o, ch) do { \
            _Pragma("unroll") for (int ks = 0; ks < 2; ++ks) { \
                (o).f[ks] = *(const u32x4*)(S_UB(Rb, RW, ch, colh + 32 * ks) + lo1); \
                (o).f[2 + ks] = *(const u32x4*)(S_UB(PROJ, NPROJ, ch, arbcol + 32 * ks) + lo2); (o).f[4 + ks] = *(const u32x4*)(S_UB(PROJ, NPROJ, ch, C_V + colh + 32 * ks) + lo2); \
                (o).f[6 + ks] = *(const u32x4*)(S_UB(Bb, RW, ch, colh + 32 * ks) + lo1); (o).f[8 + ks] = *(const u32x4*)(S_UB(Kb, RW, ch, colh + 32 * ks) + lo1); \
                (o).f[10 + ks] = *(const u32x4*)(S_UB(PROJ, NPROJ, ch, C_R + colh + 32 * ks) + lo2); } } while (0)
#define S_BWRITE(o) do { _Pragma("unroll") for (int f_ = 0; f_ < 12; ++f_) *(LAS u32x4*)(BS + (cw * 12 + f_) * 1024 + lane * 16) = (o).f[f_]; } while (0)
#define S_BF(f_) (*(const LAS u32x4*)(BS + (cw * 12 + (f_)) * 1024 + lane * 16))
#define S_FRAG(BUF, nt, ks) (*(const LAS u32x4*)((BUF) + (16 * (nt) + m) * 72 + kq * 8 + 32 * (ks)))
#define S_PUT4(BUF, nt, v) do { u32x2 o_; o_.x = pk2((v)[0], (v)[1]); o_.y = pk2((v)[2], (v)[3]); *(LAS u32x2*)((BUF) + (16 * (nt) + m) * 72 + 16 * cw + 4 * kq) = o_; } while (0)
#define S_CHUNK(oa, ch, cur) do { \
            { f32x4 x[4]; \
              _Pragma("unroll") for (int nt = 0; nt < 4; ++nt) x[nt] = mfma16((oa).at[0], S_FRAG(Ht + (cur) * 4608, nt, 0), (f32x4){0.f, 0.f, 0.f, 0.f}); \
              _Pragma("unroll") for (int nt = 0; nt < 4; ++nt) x[nt] = mfma16((oa).at[1], S_FRAG(Ht + (cur) * 4608, nt, 1), x[nt]); \
              _Pragma("unroll") for (int nt = 0; nt < 4; ++nt) x[nt] = mfma16((oa).aak[0], S_FRAG(Vt + (cur) * 4608, nt, 0), x[nt]); \
              _Pragma("unroll") for (int nt = 0; nt < 4; ++nt) x[nt] = mfma16((oa).aak[1], S_FRAG(Vt + (cur) * 4608, nt, 1), x[nt]); \
              _Pragma("unroll") for (int nt = 0; nt < 4; ++nt) S_PUT4(Xt, nt, x[nt]); } \
            LBAR(); \
            { f32x4 u_[4]; const u32x4 f0 = S_BF(10), f1 = S_BF(11); \
              _Pragma("unroll") for (int nt = 0; nt < 4; ++nt) u_[nt] = mfma16(f0, S_FRAG(Xt, nt, 0), (f32x4){0.f, 0.f, 0.f, 0.f}); \
              _Pragma("unroll") for (int nt = 0; nt < 4; ++nt) u_[nt] = mfma16(f1, S_FRAG(Xt, nt, 1), u_[nt]); \
              _Pragma("unroll") for (int nt = 0; nt < 4; ++nt) S_PUT4(Ut, nt, u_[nt]); } \
            LBAR(); \
            { f32x4 y[4]; \
              { const u32x4 f0 = S_BF(0), f1 = S_BF(1); \
                _Pragma("unroll") for (int nt = 0; nt < 4; ++nt) y[nt] = mfma16(f0, S_FRAG(Ht + (cur) * 4608, nt, 0), (f32x4){0.f, 0.f, 0.f, 0.f}); \
                _Pragma("unroll") for (int nt = 0; nt < 4; ++nt) y[nt] = mfma16(f1, S_FRAG(Ht + (cur) * 4608, nt, 1), y[nt]); } \
              { const u32x4 f0 = S_BF(2), f1 = S_BF(3); \
                _Pragma("unroll") for (int nt = 0; nt < 4; ++nt) y[nt] = mfma16(f0, S_FRAG(Ut, nt, 0), y[nt]); \
                _Pragma("unroll") for (int nt = 0; nt < 4; ++nt) y[nt] = mfma16(f1, S_FRAG(Ut, nt, 1), y[nt]); } \
              { const u32x4 f0 = S_BF(4), f1 = S_BF(5); \
                _Pragma("unroll") for (int nt = 0; nt < 4; ++nt) y[nt] = mfma16(f0, S_FRAG(Vt + (cur) * 4608, nt, 0), y[nt]); \
                _Pragma("unroll") for (int nt = 0; nt < 4; ++nt) y[nt] = mfma16(f1, S_FRAG(Vt + (cur) * 4608, nt, 1), y[nt]); } \
              bf16_t* ybase_ = (bf16_t*)PROJb + (rowb + (size_t)(ch) * 64 + 16 * cw + 4 * kq) * (size_t)NPROJ + C_K + colh + m; \
              _Pragma("unroll") for (int nt = 0; nt < 4; ++nt) _Pragma("unroll") for (int i = 0; i < 4; ++i) ybase_[(size_t)i * NPROJ + 16 * nt] = (bf16_t)f2bf(y[nt][i]); } \
            _Pragma("unroll") for (int nt = 0; nt < 4; ++nt) hreg[nt] = hreg[nt] * (oa).dc; \
            { const u32x4 f0 = S_BF(6), f1 = S_BF(7); \
              _Pragma("unroll") for (int nt = 0; nt < 4; ++nt) hreg[nt] = mfma16(f0, S_FRAG(Ut, nt, 0), hreg[nt]); \
              _Pragma("unroll") for (int nt = 0; nt < 4; ++nt) hreg[nt] = mfma16(f1, S_FRAG(Ut, nt, 1), hreg[nt]); } \
            { const u32x4 f0 = S_BF(8), f1 = S_BF(9); \
              _Pragma("unroll") for (int nt = 0; nt < 4; ++nt) hreg[nt] = mfma16(f0, S_FRAG(Vt + (cur) * 4608, nt, 0), hreg[nt]); \
              _Pragma("unroll") for (int nt = 0; nt < 4; ++nt) hreg[nt] = mfma16(f1, S_FRAG(Vt + (cur) * 4608, nt, 1), hreg[nt]); } \
            _Pragma("unroll") for (int nt = 0; nt < 4; ++nt) S_PUT4(Ht + ((cur) ^ 1) * 4608, nt, hreg[nt]); \
            LBAR(); } while (0)
#define S_CONSV(ch, VN, cur) do { if ((ch) + 1 < 64) S_VWRITE((cur) ^ 1, VN); if ((ch) + 4 < 64) S_VLOAD((ch) + 4, VN); } while (0)
#define S_PROD(ch, BC, BN, VN, cur) do { \
            if ((ch) + 2 < 64) S_OLOAD_B(BN, (ch) + 2); \
            S_BWRITE(BC); S_CONSV(ch, VN, cur); \
            LBAR(); LBAR(); LBAR(); } while (0)
        for (int i = tid; i < 2304; i += NTHREADS) ((LAS unsigned*)Ht)[i] = 0u;
        if (wave >= 4) {
            SOpsB b0, b1, b2; u32x4 va0, va1, va2;
            S_VLOAD(0, 0); S_OLOAD_B(b0, 0); S_OLOAD_B(b1, 1); S_VWRITE(0, 0); S_VLOAD(1, 1); S_VLOAD(2, 2); S_VLOAD(3, 0);
            LBAR();
            for (int ch = 0; ch < 63; ch += 3) {
                S_PROD(ch,     b0, b2, 1, ch & 1);
                S_PROD(ch + 1, b1, b0, 2, (ch + 1) & 1);
                S_PROD(ch + 2, b2, b1, 0, ch & 1);
            }
            S_PROD(63, b0, b2, 1, 1);
        } else {
            SOpsA a0, a1, a2; u32x4 va0, va1, va2;
            f32x4 hreg[4];
#pragma unroll
            for (int nt = 0; nt < 4; ++nt) hreg[nt] = (f32x4){0.f, 0.f, 0.f, 0.f};
            S_VLOAD(0, 0); S_OLOAD_A(a0, 0); S_OLOAD_A(a1, 1); S_VWRITE(0, 0); S_VLOAD(1, 1); S_VLOAD(2, 2); S_VLOAD(3, 0);
            LBAR();
            for (int ch = 0; ch < 63; ch += 3) {
                S_OLOAD_A(a2, ch + 2);                      S_CONSV(ch,     1, ch & 1);       S_CHUNK(a0, ch, ch & 1);
                S_OLOAD_A(a0, ch + 3);                      S_CONSV(ch + 1, 2, (ch + 1) & 1); S_CHUNK(a1, ch + 1, (ch + 1) & 1);
                if (ch + 4 < 64) S_OLOAD_A(a1, ch + 4);     S_CONSV(ch + 2, 0, ch & 1);       S_CHUNK(a2, ch + 2, ch & 1);
            }
            S_CONSV(63, 1, 1); S_CHUNK(a0, 63, 1);
        }
        LBAR();
#undef S_VLOAD
#undef S_VPUT
#undef S_VWRITE
#undef S_UB
#undef S_OLOAD_A
#undef S_OLOAD_B
#undef S_BWRITE
#undef S_BF
#undef S_FRAG
#undef S_PUT4
#undef S_CHUNK
#undef S_PROD
#undef S_CONSV
    }
}

__device__ __forceinline__ float max3f_(float a, float b, float c) { float r; asm("v_max3_f32 %0, %1, %2, %3" : "=v"(r) : "v"(a), "v"(b), "v"(c)); return r; }
__device__ __forceinline__ int crow(int r, int hi) { return (r & 3) + 8 * (r >> 2) + 4 * hi; }

__device__ __forceinline__ void attn_unit(const Params& p, LAS unsigned char* lds, int b, int h, int qb) {
    constexpr int BUFB = 36352, KOFF = 0, VOFF = 18432, BOFF = 35840, VS = 136;
    constexpr float C2 = 0.125f * LOG2E;
    const int tid = threadIdx.x, lane = tid & 63, wave = __builtin_amdgcn_readfirstlane(tid >> 6), r32 = lane & 31, hi = lane >> 5;
    bf16_t* PROJ = (bf16_t*)(p.ws + WS_PROJ);
    const float* cumg = (const float*)(p.ws + WS_CUM) + (size_t)(b * NH + h) * SEQ;
    const size_t rowbase = (size_t)b * SEQ; const int q0 = qb * 256, qw = q0 + wave * 32;
    bf16x8 qr[4];
    {   const bf16_t* Qp = PROJ + (rowbase + qw + r32) * NPROJ + C_FQ + h * 64;
#pragma unroll
        for (int d0 = 0; d0 < 4; ++d0) qr[d0] = *(const bf16x8*)(Qp + d0 * 16 + hi * 8); }
    const bf16_t* Kg = PROJ + rowbase * NPROJ + C_FK + h * 64; const bf16_t* Vg = PROJ + rowbase * NPROJ + C_FV + h * 64;
    const int NS = (q0 + 256) / 128;
    const int lkey = tid >> 3, d8 = (tid & 7) * 8;
    u32x4 ka0_, kb0_, va0_, vb0_, ka1_, kb1_, va1_, vb1_; float bias0_ = 0.f, bias1_ = 0.f;
#define ATT_LOAD(st, S) do { const size_t k0_ = (size_t)(st) * 128; \
        ka##S##_ = *(const u32x4*)(Kg + (k0_ + lkey) * NPROJ + d8); kb##S##_ = *(const u32x4*)(Kg + (k0_ + 64 + lkey) * NPROJ + d8); \
        va##S##_ = *(const u32x4*)(Vg + (k0_ + lane) * NPROJ + wave * 8); vb##S##_ = *(const u32x4*)(Vg + (k0_ + 64 + lane) * NPROJ + wave * 8); \
        if (tid < 128) bias##S##_ = -cumg[(st) * 128 + tid] * LOG2E; } while (0)
#define ATT_VPUT(vt, v) do { (vt)[0] = (bf16_t)((v).x & 0xffffu); (vt)[VS] = (bf16_t)((v).x >> 16); (vt)[2 * VS] = (bf16_t)((v).y & 0xffffu); (vt)[3 * VS] = (bf16_t)((v).y >> 16); \
        (vt)[4 * VS] = (bf16_t)((v).z & 0xffffu); (vt)[5 * VS] = (bf16_t)((v).z >> 16); (vt)[6 * VS] = (bf16_t)((v).w & 0xffffu); (vt)[7 * VS] = (bf16_t)((v).w >> 16); } while (0)
#define ATT_WRITE(cb, S) do { LAS unsigned char* B_ = lds + (cb) * BUFB; \
        *(LAS u32x4*)(B_ + KOFF + lkey * 144 + d8 * 2) = ka##S##_; *(LAS u32x4*)(B_ + KOFF + (64 + lkey) * 144 + d8 * 2) = kb##S##_; \
        LAS bf16_t* vt_ = (LAS bf16_t*)(B_ + VOFF) + (wave * 8) * VS + lane;     \
        ATT_VPUT(vt_, va##S##_); ATT_VPUT(vt_ + 64, vb##S##_); \
        if (tid < 128) ((LAS float*)(B_ + BOFF))[tid] = bias##S##_; } while (0)
    ATT_LOAD(0, 0); ATT_LOAD(1, 1); ATT_WRITE(0, 0);
    LBAR();
    float m = -1e30f, l = 0.f; f32x16 o[2];
#pragma unroll
    for (int r = 0; r < 16; ++r) { o[0][r] = 0.f; o[1][r] = 0.f; }
    for (int s2 = 0; s2 < NS; s2 += 2) {
#pragma unroll
      for (int js = 0; js < 2; ++js) {
        const int st = s2 + js, cb = js;
        if (st + 2 < NS) { if (js == 0) ATT_LOAD(st + 2, 0); else ATT_LOAD(st + 2, 1); }
#pragma unroll
        for (int sub = 0; sub < 2; ++sub) {
          const int kt = 2 * st + sub;
          if (kt * 64 <= qw + 31) {
            const LAS unsigned char* Bf = lds + cb * BUFB;
            f32x16 p0, p1;
#pragma unroll
            for (int r = 0; r < 16; ++r) { p0[r] = 0.f; p1[r] = 0.f; }
#pragma unroll
            for (int d0 = 0; d0 < 4; ++d0) {
                const bf16x8 ka0 = *(const LAS bf16x8*)(Bf + KOFF + (sub * 64 + r32) * 144 + (d0 * 16 + hi * 8) * 2);
                const bf16x8 ka1 = *(const LAS bf16x8*)(Bf + KOFF + (sub * 64 + 32 + r32) * 144 + (d0 * 16 + hi * 8) * 2);
                p0 = __builtin_amdgcn_mfma_f32_32x32x16_bf16(ka0, qr[d0], p0, 0, 0, 0);
                p1 = __builtin_amdgcn_mfma_f32_32x32x16_bf16(ka1, qr[d0], p1, 0, 0, 0);
            }
            const LAS float* kbp = (const LAS float*)(Bf + BOFF) + sub * 64;
#pragma unroll
            for (int g = 0; g < 4; ++g) {
                const f32x4 kb0 = *(const LAS f32x4*)(kbp + 8 * g + 4 * hi), kb1 = *(const LAS f32x4*)(kbp + 32 + 8 * g + 4 * hi);
#pragma unroll
                for (int j = 0; j < 4; ++j) { p0[4 * g + j] = p0[4 * g + j] * C2 + kb0[j]; p1[4 * g + j] = p1[4 * g + j] * C2 + kb1[j]; }
            }
            if (kt * 64 + 63 > qw) {
                asm volatile("" ::: "memory");
                const int qrel = qw + r32 - kt * 64;
#pragma unroll
                for (int r = 0; r < 16; ++r) { const int key = crow(r, hi); if (key > qrel) p0[r] = -INFINITY; if (key + 32 > qrel) p1[r] = -INFINITY; }
                asm volatile("" ::: "memory");
            }
            float rm = max3f_(p0[0], p1[0], p0[1]);
            rm = max3f_(rm, p1[1], p0[2]);
#pragma unroll
            for (int r = 2; r < 15; ++r) rm = max3f_(rm, p1[r], p0[r + 1]);
            rm = fmaxf(rm, p1[15]);
            { const auto rr = __builtin_amdgcn_permlane32_swap(__float_as_uint(rm), __float_as_uint(rm), false, false); rm = fmaxf(__uint_as_float(rr[0]), __uint_as_float(rr[1])); }
            const float mnew = fmaxf(m, rm), alpha = __builtin_amdgcn_exp2f(m - mnew); m = mnew;
            float rs = 0.f;
#pragma unroll
            for (int r = 0; r < 16; ++r) { p0[r] = __builtin_amdgcn_exp2f(p0[r] - mnew); p1[r] = __builtin_amdgcn_exp2f(p1[r] - mnew); rs += p0[r] + p1[r]; }
            l = l * alpha + rs;
#pragma unroll
            for (int r = 0; r < 16; ++r) { o[0][r] *= alpha; o[1][r] *= alpha; }
            u32x4 pw[4];
            pw[0] = (u32x4){pk2(p0[0], p0[1]), pk2(p0[2], p0[3]), pk2(p0[4], p0[5]), pk2(p0[6], p0[7])};
            pw[1] = (u32x4){pk2(p0[8], p0[9]), pk2(p0[10], p0[11]), pk2(p0[12], p0[13]), pk2(p0[14], p0[15])};
            pw[2] = (u32x4){pk2(p1[0], p1[1]), pk2(p1[2], p1[3]), pk2(p1[4], p1[5]), pk2(p1[6], p1[7])};
            pw[3] = (u32x4){pk2(p1[8], p1[9]), pk2(p1[10], p1[11]), pk2(p1[12], p1[13]), pk2(p1[14], p1[15])};
#pragma unroll
            for (int sl = 0; sl < 4; ++sl)
#pragma unroll
                for (int d0 = 0; d0 < 2; ++d0) {
                    const int base = sub * 64 + 32 * (sl >> 1) + 16 * (sl & 1) + 4 * hi;
                    const LAS unsigned char* vp = Bf + VOFF + (d0 * 32 + r32) * (VS * 2) + base * 2;
                    const u32x2 lo = *(const LAS u32x2*)vp, hh = *(const LAS u32x2*)(vp + 16);
                    const u32x4 vv = {lo.x, lo.y, hh.x, hh.y};
                    o[d0] = __builtin_amdgcn_mfma_f32_32x32x16_bf16(__builtin_bit_cast(bf16x8, vv), __builtin_bit_cast(bf16x8, pw[sl]), o[d0], 0, 0, 0);
                }
          }
        }
        if (st + 1 < NS) { if (js == 0) ATT_WRITE(1, 1); else ATT_WRITE(0, 0); }
        LBAR();
      }
    }
#undef ATT_LOAD
#undef ATT_VPUT
#undef ATT_WRITE
    { const auto rr = __builtin_amdgcn_permlane32_swap(__float_as_uint(l), __float_as_uint(l), false, false); l = __uint_as_float(rr[0]) + __uint_as_float(rr[1]); }
    const float rl = 1.f / l;
    bf16_t* Op = PROJ + (rowbase + qw + r32) * NPROJ + C_FQ + h * 64 + 4 * hi;
#pragma unroll
    for (int d0 = 0; d0 < 2; ++d0)
#pragma unroll
        for (int g = 0; g < 4; ++g) { u32x2 ov; ov.x = pk2(o[d0][4 * g] * rl, o[d0][4 * g + 1] * rl); ov.y = pk2(o[d0][4 * g + 2] * rl, o[d0][4 * g + 3] * rl);
            *(u32x2*)(Op + d0 * 32 + 8 * g) = ov; }
}

__device__ __forceinline__ void phase_attn(const Params& p, LAS unsigned char* lds) {
    unsigned* ctr = (unsigned*)(p.ws + WS_CTL) + 3600;
    volatile LAS unsigned* slot = (volatile LAS unsigned*)(lds + 131088);
    for (;;) {
        __syncthreads();
        if (threadIdx.x == 0) *slot = atomicAdd(ctr, 1u);
        __syncthreads();
        const unsigned u = *slot;
        if (u >= 1024u) break;
        const int qb = 15 - (int)(u >> 6), bh = (int)(u & 63u);
        attn_unit(p, lds, bh >> 3, bh & 7, qb);
    }
}

__device__ __forceinline__ void phase_fin(const Params& p) {
    const int gt = blockIdx.x * NTHREADS + threadIdx.x, NT = gridDim.x * NTHREADS;
    unsigned char* ws = p.ws;
    const bf16_t* Vb = (const bf16_t*)p.out + (size_t)2 * T * RW;
    const bf16_t* Gb = (const bf16_t*)(ws + WS_G); const float* BON = (const float*)(ws + WS_BON);
    unsigned char* PROJb = ws + WS_PROJ;
    const int c = (gt & 63) * 8;
    float lnw[8], lnb[8];
#pragma unroll
    for (int j = 0; j < 8; ++j) { lnw[j] = p.in[I_LNW][c + j]; lnb[j] = p.in[I_LNB][c + j]; }
    for (int idx = gt; idx < T * 64; idx += NT) {
        const int t = idx >> 6;
        float y[8];
        unpack8(*(const u32x4*)((const bf16_t*)PROJb + (size_t)t * NPROJ + C_K + c), y);
        const size_t o = (size_t)t * RW + c;
        float v[8], g[8];
        unpack8(*(const u32x4*)(Vb + o), v); unpack8(*(const u32x4*)(Gb + o), g);
        const float sb = BON[(size_t)t * NH + (c >> 6)];
        float s1 = 0.f;
#pragma unroll
        for (int j = 0; j < 8; ++j) s1 += y[j];
        s1 = sum8(s1);
        const float mean = s1 * (1.f / 64.f);
        float s2 = 0.f;
#pragma unroll
        for (int j = 0; j < 8; ++j) { y[j] -= mean; s2 += y[j] * y[j]; }
        s2 = sum8(s2);
        const float rstd = rsqrtf(s2 * (1.f / 64.f) + GN_EPS);
#pragma unroll
        for (int j = 0; j < 8; ++j) y[j] = ((y[j] * rstd * lnw[j] + lnb[j]) + sb * v[j]) * g[j];
        *(u32x4*)((bf16_t*)PROJb + (size_t)t * NPROJ + C_R + c) = pack8(y);
    }
}

#define XB_TMO      128
#define XB_XCNT(j)  (256  + 64 * (j))
#define XB_XSUB(j)  (1280 + 64 * (j))
#define XB_XGEN(j)  (2304 + 64 * (j))
#define XB_TOP      3328
#define XB_TOPGEN   3392
#define XCD_BAR_WORDS 3456
#define XB_SPIN_CAP (1u << 18)

__device__ __forceinline__ unsigned xb_ld(unsigned* p)              { return __hip_atomic_load(p, __ATOMIC_RELAXED, __HIP_MEMORY_SCOPE_AGENT); }
__device__ __forceinline__ unsigned xb_add(unsigned* p, unsigned v) { return __hip_atomic_fetch_add(p, v, __ATOMIC_RELAXED, __HIP_MEMORY_SCOPE_AGENT); }
__device__ __forceinline__ unsigned xb_xcc_id() { return (unsigned)__builtin_amdgcn_s_getreg((3 << 11) | 20) & 0xFu; }
#define XB_SPIN(cond, bar) do { unsigned _sp = 0; while (cond) { __builtin_amdgcn_s_sleep(1); \
    if ((++_sp & 255u) == 0u) { if (xb_ld(&(bar)[XB_TMO])) break; if (_sp > XB_SPIN_CAP) { atomicAdd(&(bar)[XB_TMO], 1u); break; } } } } while (0)

struct XcdBarrier {
    unsigned* bar; unsigned x;
    volatile LAS unsigned* st;
};

__device__ __forceinline__ XcdBarrier xcd_barrier_post(unsigned* bar, volatile LAS unsigned* st) {
    XcdBarrier b; b.bar = bar; b.x = xb_xcc_id(); b.st = st;
    if (threadIdx.x == 0) (void)xb_add(&bar[XB_XCNT(b.x)], 1u);
    return b;
}
__device__ __forceinline__ void xcd_barrier_complete(unsigned* bar, unsigned x, unsigned& nloc, unsigned& nx) {
    const unsigned G = gridDim.x * gridDim.y * gridDim.z;
    unsigned sum, cnt, mine, sp = 0u;
    for (;;) {
        sum = 0u; cnt = 0u; mine = 0u;
#pragma unroll
        for (unsigned j = 0; j < 16; ++j) { const unsigned c = xb_ld(&bar[XB_XCNT(j)]); sum += c; cnt += (c > 0u) ? 1u : 0u; mine = (j == x) ? c : mine; }
        if (sum == G) break;
        __builtin_amdgcn_s_sleep(1);
        if ((++sp & 255u) == 0u) { if (xb_ld(&bar[XB_TMO])) break; if (sp > XB_SPIN_CAP) { atomicAdd(&bar[XB_TMO], 1u); break; } }
    }
    nloc = mine > 0u ? mine : 1u; nx = cnt > 0u ? cnt : 1u;
}

__device__ __forceinline__ void xcd_barrier(const XcdBarrier& b) {
    asm volatile("s_waitcnt vmcnt(0)" ::: "memory");
    __syncthreads();
    if (threadIdx.x == 0) {
        unsigned* bar = b.bar;
        __builtin_amdgcn_s_waitcnt(0);
        unsigned nloc = b.st[0], nx = b.st[1];
        if (nloc == 0u) { xcd_barrier_complete(bar, b.x, nloc, nx); b.st[0] = nloc; b.st[1] = nx; }
        const unsigned old = xb_add(&bar[XB_XSUB(b.x)], 1u);
        const unsigned gen = old / nloc;
        if (old + 1u == (gen + 1u) * nloc) {
            __builtin_amdgcn_fence(__ATOMIC_RELEASE, "agent");
            asm volatile("s_waitcnt vmcnt(0)" ::: "memory");
            const unsigned og = xb_add(&bar[XB_TOP], 1u);
            const unsigned tg = og / nx;
            if (og + 1u == (tg + 1u) * nx) xb_add(&bar[XB_TOPGEN], 1u);
            else XB_SPIN(xb_ld(&bar[XB_TOPGEN]) == tg, bar);
            __builtin_amdgcn_fence(__ATOMIC_ACQUIRE, "agent");
            xb_add(&bar[XB_XGEN(b.x)], 1u);
            asm volatile("s_waitcnt vmcnt(0)" ::: "memory");
        } else {
            XB_SPIN(xb_ld(&bar[XB_XGEN(b.x)]) == gen, bar);
            __builtin_amdgcn_fence(__ATOMIC_ACQUIRE, "agent");
            asm volatile("s_waitcnt vmcnt(0)" ::: "memory");
        }
    }
    __syncthreads();
}


#ifndef PROBE_PHASE
#define PROBE_PHASE -1
#endif
#ifndef PROBE_SYNCS
#define PROBE_SYNCS 0
#endif
#ifndef PROBE_MULT
#define PROBE_MULT 3
#endif
#define PROBE_T0(k) unsigned long long _pt0 = 0; if (PROBE_PHASE == (k)) _pt0 = __builtin_amdgcn_s_memrealtime();
#define PROBE_T1(k) if (PROBE_PHASE == (k)) { __syncthreads(); const unsigned long long _t1 = __builtin_amdgcn_s_memrealtime(); const unsigned long long _end = _t1 + PROBE_MULT * (_t1 - _pt0); while (__builtin_amdgcn_s_memrealtime() < _end) __builtin_amdgcn_s_sleep(16); }
__global__ void __launch_bounds__(NTHREADS, 2) fwd_kernel(Params p) {
    extern __shared__ __attribute__((aligned(16))) unsigned char lds_raw[];
    LAS unsigned char* lds = (LAS unsigned char*)lds_raw;
    cg::grid_group grid = cg::this_grid();
    const int lo = p.ph_lo, hi = p.ph_hi;
    volatile LAS unsigned* bst = (volatile LAS unsigned*)(lds + 131072);
    if (hi - lo > 1) { if (threadIdx.x < 2) bst[threadIdx.x] = 0u; __syncthreads(); (void)xcd_barrier_post((unsigned*)(p.ws + WS_CTL), bst); }
    if (hi < 0) grid.sync();
    unsigned char* ws = p.ws;
    float* mod = (float*)(ws + WS_MOD);
    bf16_t* PROJ = (bf16_t*)(ws + WS_PROJ);
    const int G = gridDim.x, bx = blockIdx.x;
#define IN(k) (lo <= (k) && (k) < hi)
#define SEAM(k) do { if (IN(k) && IN((k) + 1)) { XcdBarrier xb_; xb_.bar = (unsigned*)(p.ws + WS_CTL); xb_.x = xb_xcc_id(); xb_.st = (volatile LAS unsigned*)(lds + 131072); xcd_barrier(xb_); } } while (0)
    if (IN(0)) { PROBE_T0(0) phase_p0(p, lds); PROBE_T1(0) } SEAM(0);
    if (IN(1)) { PROBE_T0(1) phase_norm<0, false>(p.in[I_X], nullptr, p.in[I_N1G], mod, 0, 1024, (bf16_t*)(ws + WS_H), nullptr); PROBE_T1(1) } SEAM(1);
    if (IN(2)) { PROBE_T0(2)
        pg8::Gemm g{(const bf16_t*)(ws + WS_H), (const bf16_t*)(ws + WS_WIN), T, NPROJ, DM, DM}; pg8::StaticOrder S; S.init(T, NPROJ, G, bx);
        pg8::Epi<0> E{PROJ, NPROJ, nullptr, nullptr, nullptr, nullptr, 0};
        pg8::gemm_phase(lds, g, S, E);
    PROBE_T1(2) } SEAM(2);
    if (IN(3)) { PROBE_T0(3) phase_lrin(p, lds); PROBE_T1(3) } SEAM(3);
    if (IN(4)) { PROBE_T0(4)
        pg8::Gemm g{(const bf16_t*)(ws + WS_LR), (const bf16_t*)(ws + WS_WLR), T, 1536, 256, 256}; pg8::StaticOrder S; S.init(T, 1536, G, bx);
        pg8::Epi<5> E{(bf16_t*)(ws + WS_AI), RW, nullptr, p.in[I_DBASE], p.in[I_IBASE], nullptr, 0, (bf16_t*)(ws + WS_W16), (bf16_t*)(ws + WS_G)};
        pg8::gemm_phase(lds, g, S, E);
    PROBE_T1(4) } SEAM(4);
    if (IN(5)) { PROBE_T0(5) phase_rkvab(p); PROBE_T1(5) } SEAM(5);
    if (IN(6)) { PROBE_T0(6) phase_x1(p, lds); PROBE_T1(6) } SEAM(6);
    if (IN(7)) { PROBE_T0(7) phase_s(p, lds); PROBE_T1(7) }
    if (IN(8)) { PROBE_T0(8) phase_attn(p, lds); PROBE_T1(8) } SEAM(8);
    if (IN(9)) { PROBE_T0(9) phase_fin(p); PROBE_T1(9) } SEAM(9);
    if (IN(10)) { PROBE_T0(10)
        {   pg8::Gemm g{PROJ + C_R, (const bf16_t*)(ws + WS_WOA), T, DM, RW, NPROJ}; pg8::StaticOrder S; S.init(T, DM, G, bx);
            pg8::Epi<2> E{(bf16_t*)(ws + WS_H), DM, nullptr, nullptr, nullptr, PROJ, C_GA};
            pg8::gemm_phase(lds, g, S, E); }
        {   pg8::Gemm g{PROJ + C_FQ, (const bf16_t*)(ws + WS_WOB), T, DM, RW, NPROJ}; pg8::StaticOrder S; S.init(T, DM, G, bx);
            pg8::Epi<3> E{(bf16_t*)(ws + WS_H), DM, nullptr, nullptr, nullptr, PROJ, C_GB};
            pg8::gemm_phase(lds, g, S, E); }
    PROBE_T1(10) } SEAM(10);
    if (IN(11)) { PROBE_T0(11)
        pg8::Gemm g{(const bf16_t*)(ws + WS_H), (const bf16_t*)(ws + WS_WOUT), T, DM, DM, DM}; pg8::StaticOrder S; S.init(T, DM, G, bx);
        pg8::Epi<7> E{(bf16_t*)(ws + WS_X1B), DM, nullptr, p.in[I_X], mod + 2048, nullptr, 0};
        pg8::gemm_phase(lds, g, S, E);
    PROBE_T1(11) } SEAM(11);
    if (IN(12)) { PROBE_T0(12) phase_norm<0, true>(nullptr, (const bf16_t*)(ws + WS_X1B), p.in[I_N2G], mod, 3072, 4096, (bf16_t*)(ws + WS_H), nullptr); PROBE_T1(12) } SEAM(12);
    if (IN(13)) { PROBE_T0(13)
        pg8::Gemm g{(const bf16_t*)(ws + WS_H), (const bf16_t*)(ws + WS_WFF1), T, DFF, DM, DM}; pg8::StaticOrder S; S.init(T, DFF, G, bx);
        pg8::Epi<1> E{PROJ, DFF, nullptr, nullptr, nullptr, nullptr, 0};
        pg8::gemm_phase(lds, g, S, E);
    PROBE_T1(13) } SEAM(13);
    if (IN(14)) { PROBE_T0(14)
        pg8::Gemm g{PROJ, (const bf16_t*)(ws + WS_WFF2), T, DM, DFF, DFF}; pg8::StaticOrder S; S.init(T, DM, G, bx);
        pg8::Epi<8> E{(bf16_t*)(ws + WS_H), DM, nullptr, nullptr, mod + 5120, (const bf16_t*)(ws + WS_X1B), 0};
        pg8::gemm_phase(lds, g, S, E);
    PROBE_T1(14) } SEAM(14);
    if (IN(15)) { PROBE_T0(15) phase_norm<1, true>(nullptr, (const bf16_t*)(ws + WS_H), p.in[I_FG], nullptr, 0, 0, nullptr, p.out); PROBE_T1(15) }
#undef IN
#undef SEAM
}

extern "C" void kernel_launch(void* const* d_in, const int* in_sizes, int n_in, void* d_out, int out_size, void* d_ws, size_t ws_size, hipStream_t stream) {
    static int grid = 0;
    if (grid == 0) {
        if (n_in != 25 || out_size != T * DM || ws_size < WS_END) { fprintf(stderr, "kernel_launch: unexpected shapes (n_in %d out %d ws %zu)\n", n_in, out_size, ws_size); grid = -1; return; }
        int dev = 0, cus = 0, per_cu = 0;
        hipGetDevice(&dev);
        hipDeviceGetAttribute(&cus, hipDeviceAttributeMultiprocessorCount, dev);
        if (hipFuncSetAttribute((const void*)fwd_kernel, hipFuncAttributeMaxDynamicSharedMemorySize, LDS_BYTES) != hipSuccess) { fprintf(stderr, "kernel_launch: hipFuncSetAttribute failed\n"); grid = -1; return; }
        if (hipOccupancyMaxActiveBlocksPerMultiprocessor(&per_cu, (const void*)fwd_kernel, NTHREADS, LDS_BYTES) != hipSuccess || per_cu < 1) { fprintf(stderr, "kernel_launch: occupancy query failed (%d)\n", per_cu); (void)hipGetLastError(); per_cu = 1; }
        grid = cus * (per_cu > 1 ? 1 : per_cu);
        if (grid < 64) { fprintf(stderr, "kernel_launch: grid %d < 64 not supported\n", grid); grid = -1; return; }
        fprintf(stderr, "kernel_launch: grid %d (cus %d, per_cu %d)\n", grid, cus, per_cu);
    }
    if (grid < 0) return;
    Params p{};
    for (int i = 0; i < 25; ++i) p.in[i] = (const float*)d_in[i];
    p.out = (float*)d_out; p.ws = (unsigned char*)d_ws;
#if N_LAUNCH_MODE == 0
    if (hipMemsetAsync((char*)d_ws + WS_CTL, 0, CTL_BYTES, stream) != hipSuccess) { fprintf(stderr, "kernel_launch: memset failed\n"); return; }
    p.ph_lo = 0; p.ph_hi = NPHASE;
    void* args[] = {&p};
    hipError_t e = hipLaunchCooperativeKernel((const void*)fwd_kernel, dim3(grid), dim3(NTHREADS), args, LDS_BYTES, stream);
    if (e != hipSuccess) fprintf(stderr, "cooperative launch failed: %s (grid %d)\n", hipGetErrorString(e), grid);
#else
    for (int ph = 0; ph < NPHASE; ++ph) {
        if (ph == 8) continue;
        p.ph_lo = ph; p.ph_hi = (ph == 7) ? 9 : ph + 1;
        hipLaunchKernelGGL(fwd_kernel, dim3(grid), dim3(NTHREADS), LDS_BYTES, stream, p);
    }
#endif
}
```
